# Optimizing an MI355X kernel written in HIP

```python
import math
import jax, jax.numpy as jnp
from jax import lax
import numpy as np

D_MODEL = 1024
BATCH = 16
SEQ = 256
DEPTH = 1
DEC_BATCH = 2
DEC_SEQ = 1024
PAST_LEN = 512

GRID_W = 64
ML_HEADS = 4
ML_HEAD_DIM = D_MODEL // ML_HEADS
ML_WIDTH = ML_HEADS * ML_HEAD_DIM
DA_HEADS = 8
DA_HEAD_DIM = D_MODEL // (2 * DA_HEADS)
DA_V_DIM = 2 * DA_HEAD_DIM
DA_QK_WIDTH = 2 * DA_HEADS * DA_HEAD_DIM
DA_WIDTH = DA_HEADS * DA_V_DIM
D_FF = 2816
N_MOD = 9
N_GATE_COLS = 4 * ML_HEADS
CHUNK = 128
Q_BLOCK = 128
ROPE_BASE = 10000.0
EPS = 1e-6
IN_SIZES = (ML_WIDTH, ML_WIDTH, ML_WIDTH, ML_WIDTH, N_GATE_COLS,
            DA_QK_WIDTH, DA_QK_WIDTH, DA_WIDTH, D_MODEL, D_MODEL)
D_IN = 4 * ML_WIDTH + N_GATE_COLS + 2 * DA_QK_WIDTH + DA_WIDTH + 2 * D_MODEL

kernel_name = 'diffusion_hybrid_mlstm_diffattn_step'


def rmsnorm(x, g):
    xf = x.astype(jnp.float32)
    y = xf * lax.rsqrt(jnp.mean(xf * xf, axis=-1, keepdims=True) + EPS)
    return (y * g.astype(jnp.float32)).astype(x.dtype)


def adaln(cvec, w, b):
    m = jax.nn.silu(cvec) @ w + b
    return m.reshape(cvec.shape[0], N_MOD, D_MODEL)


def swiglu(h, w1, w3, w2):
    return (jax.nn.silu(h @ w1) * (h @ w3)) @ w2


def split_cols(proj):
    idx = []
    acc = 0
    for s in IN_SIZES[:-1]:
        acc += s
        idx.append(acc)
    return jnp.split(proj, idx, axis=-1)


def _rotate(xs, pos):
    n = xs.shape[-1] // 2
    freqs = jnp.power(ROPE_BASE, -jnp.arange(n, dtype=jnp.float32) / n)
    ang = pos.astype(jnp.float32)[:, None] * freqs[None, :]
    cos = jnp.cos(ang)[None, :, None, None, :]
    sin = jnp.sin(ang)[None, :, None, None, :]
    x1, x2 = xs[..., :n], xs[..., n:]
    return jnp.concatenate([x1 * cos - x2 * sin, x2 * cos + x1 * sin], axis=-1)


def rope_2d(x):
    T = x.shape[1]
    rows = T // GRID_W
    row = jnp.repeat(jnp.arange(rows), GRID_W)
    col = jnp.tile(jnp.arange(GRID_W), rows)
    half = DA_HEAD_DIM // 2
    xf = x.astype(jnp.float32)
    out = jnp.concatenate([_rotate(xf[..., :half], row), _rotate(xf[..., half:], col)], axis=-1)
    return out.astype(x.dtype)


def diff_attention(q, k, v, lam):
    B, Tq = q.shape[0], q.shape[1]
    nb = Tq // Q_BLOCK
    kf = k.astype(jnp.float32)
    vf = v.astype(jnp.float32)
    scale = DA_HEAD_DIM ** -0.5
    qb = jnp.moveaxis(q.reshape(B, nb, Q_BLOCK, DA_HEADS, 2, DA_HEAD_DIM), 1, 0)

    def block(qi):
        s = jnp.einsum('bqhcd,bkhcd->bhcqk', qi.astype(jnp.float32), kf) * scale
        pr = jax.nn.softmax(s, axis=-1)
        w = pr[:, :, 0] - lam * pr[:, :, 1]
        return jnp.einsum('bhqk,bkhv->bqhv', w, vf)

    out = lax.map(block, qb)
    return jnp.moveaxis(out, 0, 1).reshape(B, Tq, DA_HEADS, DA_V_DIM)


def mlstm_chunkwise(q, k, v, log_i, log_f, state):
    B, H, T, d = q.shape
    nc = T // CHUNK
    chunk = lambda z: jnp.moveaxis(z.reshape(z.shape[:2] + (nc, CHUNK) + z.shape[3:]), 2, 0)
    tril = jnp.tril(jnp.ones((CHUNK, CHUNK), dtype=bool))
    C0, n0, m0 = (s.astype(jnp.float32) for s in state)

    def step(carry, xs):
        C, n, m = carry
        qc, kc, vc, ic, fc = xs
        b = jnp.cumsum(fc, axis=-1)
        log_d = jnp.where(tril, b[..., :, None] - b[..., None, :] + ic[..., None, :], -jnp.inf)
        a = b + m[..., None]
        m_t = jnp.maximum(a, jnp.max(log_d, axis=-1))
        dmat = jnp.exp(log_d - m_t[..., None])
        inter = jnp.exp(a - m_t)
        s = jnp.einsum('bhtd,bhsd->bhts', qc, kc) * dmat
        num = jnp.einsum('bhts,bhsv->bhtv', s, vc) + inter[..., None] * jnp.einsum('bhtd,bhdv->bhtv', qc, C)
        den = jnp.sum(s, axis=-1) + inter * jnp.einsum('bhtd,bhd->bht', qc, n)
        h = num / jnp.maximum(jnp.abs(den), jnp.exp(-m_t))[..., None]
        b_last = b[..., -1]
        g = b_last[..., None] - b + ic
        m_new = jnp.maximum(b_last + m, jnp.max(g, axis=-1))
        w = jnp.exp(g - m_new[..., None])
        decay = jnp.exp(b_last + m - m_new)
        C_new = decay[..., None, None] * C + jnp.einsum('bhs,bhsd,bhsv->bhdv', w, kc, vc)
        n_new = decay[..., None] * n + jnp.einsum('bhs,bhsd->bhd', w, kc)
        return (C_new, n_new, m_new), h

    final, hs = lax.scan(step, (C0, n0, m0), (chunk(q), chunk(k), chunk(v), chunk(log_i), chunk(log_f)))
    h = jnp.moveaxis(hs, 0, 2).reshape(B, H, T, d)
    return h, final


def token_mixer(h, p, l, ctx):
    B, T, _ = h.shape
    lam_init = 0.8 - 0.6 * math.exp(-0.3 * l)
    mq, mk, mv, mo, mg, dq, dk, dv, gm, gd = split_cols(h @ p['w_in'][l])
    dq = rmsnorm(dq.reshape(B, T, DA_HEADS, 2, DA_HEAD_DIM), p['g_qn'][l])
    dk = rmsnorm(dk.reshape(B, T, DA_HEADS, 2, DA_HEAD_DIM), p['g_kn'][l])
    dv = dv.reshape(B, T, DA_HEADS, DA_V_DIM)
    if ctx is None:
        keys, vals = dk, dv
        zero = (jnp.zeros((B, ML_HEADS, ML_HEAD_DIM, ML_HEAD_DIM), jnp.float32),
                jnp.zeros((B, ML_HEADS, ML_HEAD_DIM), jnp.float32),
                jnp.zeros((B, ML_HEADS), jnp.float32))
        st0_f, st0_b = zero, zero
        q_att = dq
    else:
        k_ctx, v_ctx, st0_f, st0_b = ctx
        q_att = rope_2d(dq)
        keys = jnp.concatenate([rope_2d(dk), k_ctx.astype(dk.dtype)], axis=1)
        vals = jnp.concatenate([dv, v_ctx.astype(dv.dtype)], axis=1)
    f32 = lambda z: z.astype(jnp.float32)
    lam = (jnp.exp(jnp.sum(f32(p['lam_q1'][l]) * f32(p['lam_k1'][l])))
           - jnp.exp(jnp.sum(f32(p['lam_q2'][l]) * f32(p['lam_k2'][l]))) + lam_init)
    att = diff_attention(q_att, keys, vals, lam)
    att = (rmsnorm(att, p['g_sub'][l]) * (1.0 - lam_init)).reshape(B, T, DA_WIDTH).astype(h.dtype)
    heads = lambda z: z.reshape(B, T, ML_HEADS, ML_HEAD_DIM).transpose(0, 2, 1, 3).astype(jnp.float32)
    q = heads(mq) * (ML_HEAD_DIM ** -0.5)
    k = heads(mk)
    v = heads(mv)
    gates = (mg + p['b_gate'][l]).astype(jnp.float32).reshape(B, T, 2, 2, ML_HEADS).transpose(2, 3, 0, 4, 1)
    log_i = gates[:, 0]
    log_f = jax.nn.log_sigmoid(gates[:, 1])
    h_f, st_f = mlstm_chunkwise(q, k, v, log_i[0], log_f[0], st0_f)
    rev = lambda z: jnp.flip(z, axis=2)
    h_b, st_b = mlstm_chunkwise(rev(q), rev(k), rev(v), jnp.flip(log_i[1], -1), jnp.flip(log_f[1], -1), st0_b)
    hm = (h_f + rev(h_b)).transpose(0, 2, 1, 3)
    hm = (rmsnorm(hm, p['g_mh'][l]).reshape(B, T, ML_WIDTH) * jax.nn.sigmoid(mo.astype(jnp.float32))).astype(h.dtype)
    y = jax.nn.sigmoid(gm) * (hm @ p['w_br_m'][l]) + jax.nn.sigmoid(gd) * (att @ p['w_br_d'][l])
    out = y @ p['w_out'][l]
    ctx_out = (dk, dv, st_f, st_b) if ctx is None else None
    return out, ctx_out


def layer(x, mods, l, p, ctx):
    m = [mods[:, j][:, None, :] for j in range(N_MOD)]
    g = p['g_norm'][l]
    hh = rmsnorm(x, g[0]) * (1 + m[1]) + m[0]
    x = x + 0.5 * m[2] * swiglu(hh, p['ffn1_w1'][l], p['ffn1_w3'][l], p['ffn1_w2'][l])
    hh = rmsnorm(x, g[1]) * (1 + m[4]) + m[3]
    y, ctx_out = token_mixer(hh, p, l, ctx)
    x = x + m[5] * y
    hh = rmsnorm(x, g[2]) * (1 + m[7]) + m[6]
    x = x + 0.5 * m[8] * swiglu(hh, p['ffn2_w1'][l], p['ffn2_w3'][l], p['ffn2_w2'][l])
    return x, ctx_out


def setup_inputs(seed: int = 0) -> dict:
    key = jax.random.key(seed)
    ks = iter(jax.random.split(key, 48))
    nrm = lambda shape, s: jax.random.normal(next(ks), shape, jnp.float32) * s
    D, F = D_MODEL, D_FF
    i_b = nrm((DEPTH, 2, 1, ML_HEADS), 0.1)
    f_b = jnp.linspace(3.0, 6.0, ML_HEADS) + nrm((DEPTH, 2, 1, ML_HEADS), 0.1)
    return {
        'x_prompt': nrm((BATCH, SEQ, D), 1.0),
        'x_sample': nrm((DEC_BATCH, DEC_SEQ, D), 1.0),
        'c': nrm((DEC_BATCH, D), 1.0),
        'cache_k': nrm((DEC_BATCH, DEPTH, PAST_LEN, DA_HEADS, 2, DA_HEAD_DIM), 1.0),
        'cache_v': nrm((DEC_BATCH, DEPTH, PAST_LEN, DA_HEADS, DA_V_DIM), 1.0),
        'state_C': nrm((DEC_BATCH, DEPTH, 2, ML_HEADS, ML_HEAD_DIM, ML_HEAD_DIM), 0.05),
        'state_n': nrm((DEC_BATCH, DEPTH, 2, ML_HEADS, ML_HEAD_DIM), 0.1),
        'state_m': nrm((DEC_BATCH, DEPTH, 2, ML_HEADS), 1.0),
        'c_ctx': nrm((D,), 1.0),
        'w_ada': nrm((DEPTH, D, N_MOD * D), 0.5 * D ** -0.5),
        'b_ada': nrm((DEPTH, N_MOD * D), 0.02),
        'g_norm': 1.0 + nrm((DEPTH, 3, D), 0.05),
        'ffn1_w1': nrm((DEPTH, D, F), D ** -0.5),
        'ffn1_w3': nrm((DEPTH, D, F), D ** -0.5),
        'ffn1_w2': nrm((DEPTH, F, D), F ** -0.5),
        'ffn2_w1': nrm((DEPTH, D, F), D ** -0.5),
        'ffn2_w3': nrm((DEPTH, D, F), D ** -0.5),
        'ffn2_w2': nrm((DEPTH, F, D), F ** -0.5),
        'w_in': nrm((DEPTH, D, D_IN), D ** -0.5),
        'b_gate': jnp.concatenate([i_b, f_b], axis=2).reshape(DEPTH, N_GATE_COLS),
        'g_qn': 1.0 + nrm((DEPTH, DA_HEAD_DIM), 0.05),
        'g_kn': 1.0 + nrm((DEPTH, DA_HEAD_DIM), 0.05),
        'lam_q1': nrm((DEPTH, DA_HEAD_DIM), 0.1),
        'lam_k1': nrm((DEPTH, DA_HEAD_DIM), 0.1),
        'lam_q2': nrm((DEPTH, DA_HEAD_DIM), 0.1),
        'lam_k2': nrm((DEPTH, DA_HEAD_DIM), 0.1),
        'g_sub': 1.0 + nrm((DEPTH, DA_V_DIM), 0.05),
        'g_mh': 1.0 + nrm((DEPTH, ML_HEADS, ML_HEAD_DIM), 0.05),
        'w_br_m': nrm((DEPTH, ML_WIDTH, D), ML_WIDTH ** -0.5),
        'w_br_d': nrm((DEPTH, DA_WIDTH, D), DA_WIDTH ** -0.5),
        'w_out': nrm((DEPTH, D, D), D ** -0.5),
    }


def reference(x_prompt, x_sample, c, cache_k, cache_v, state_C, state_n, state_m, c_ctx,
              w_ada, b_ada, g_norm, ffn1_w1, ffn1_w3, ffn1_w2, ffn2_w1, ffn2_w3, ffn2_w2,
              w_in, b_gate, g_qn, g_kn, lam_q1, lam_k1, lam_q2, lam_k2, g_sub, g_mh,
              w_br_m, w_br_d, w_out):
    p = dict(g_norm=g_norm, ffn1_w1=ffn1_w1, ffn1_w3=ffn1_w3, ffn1_w2=ffn1_w2,
             ffn2_w1=ffn2_w1, ffn2_w3=ffn2_w3, ffn2_w2=ffn2_w2, w_in=w_in, b_gate=b_gate,
             g_qn=g_qn, g_kn=g_kn, lam_q1=lam_q1, lam_k1=lam_k1, lam_q2=lam_q2, lam_k2=lam_k2,
             g_sub=g_sub, g_mh=g_mh, w_br_m=w_br_m, w_br_d=w_br_d, w_out=w_out)
    xp, xs = x_prompt, x_sample
    ks_, vs_, Cs, ns, ms = [], [], [], [], []
    for l in range(DEPTH):
        mods_ctx = adaln(c_ctx[None, :], w_ada[l], b_ada[l])
        xp, (k_l, v_l, st_f, st_b) = layer(xp, mods_ctx, l, p, None)
        ks_.append(k_l)
        vs_.append(v_l)
        Cs.append(jnp.stack([st_f[0], st_b[0]], axis=1))
        ns.append(jnp.stack([st_f[1], st_b[1]], axis=1))
        ms.append(jnp.stack([st_f[2], st_b[2]], axis=1))
        mods_lat = adaln(c, w_ada[l], b_ada[l])
        ctx = (cache_k[:, l], cache_v[:, l],
               (state_C[:, l, 0], state_n[:, l, 0], state_m[:, l, 0]),
               (state_C[:, l, 1], state_n[:, l, 1], state_m[:, l, 1]))
        xs, _ = layer(xs, mods_lat, l, p, ctx)
    new_k = jnp.stack(ks_, axis=1)
    new_v = jnp.stack(vs_, axis=1)
    new_C = jnp.stack(Cs, axis=1)
    new_n = jnp.stack(ns, axis=1)
    new_m = jnp.stack(ms, axis=1)
    return (xp, xs, new_k, new_v, new_C, new_n, new_m)
```

```cpp
#include <hip/hip_runtime.h>
#include <cstdio>
#include <cstdint>

#define LAS __attribute__((address_space(3)))
#define GAS __attribute__((address_space(1)))
typedef unsigned short bf16_t;
typedef short bf16x8 __attribute__((ext_vector_type(8)));
typedef short s16x4 __attribute__((ext_vector_type(4)));
typedef float f32x4 __attribute__((ext_vector_type(4)));
typedef float f32x2 __attribute__((ext_vector_type(2)));
typedef unsigned u32x4 __attribute__((ext_vector_type(4)));
typedef unsigned u32x2 __attribute__((ext_vector_type(2)));

constexpr int DM = 1024, FF = 2816, NCTX = 4096, NLAT = 2048, MROWS = NCTX + NLAT;
constexpr int DIN = 9232, NPROJ = 9216, NMOD = 9;
constexpr float EPS = 1e-6f;

constexpr size_t MiB = 1u << 20;
constexpr size_t WS_CTL = 0, CTL_ZERO_BYTES = 1 * MiB;
constexpr size_t WS_W13A = 2 * MiB, WS_W2A = 13 * MiB, WS_W13B = 19 * MiB, WS_W2B = 30 * MiB, WS_WIN = 36 * MiB, WS_WBR = 55 * MiB, WS_WOUT = 59 * MiB;
constexpr size_t WS_MISC = 61 * MiB;
constexpr size_t MISC_MODS = 0, MISC_ROPE = 192 * 1024, MISC_GS = 208 * 1024, MISC_SW = 256 * 1024, MISC_LAM = 250 * 1024;
constexpr int NWIN = 37 * 256;
constexpr int SW_A = 0, SW_C = 3 * 5632, SW_F = SW_C + 3 * NWIN, SW_END = SW_F + 3 * 5632;
constexpr size_t WS_CK = 62 * MiB, WS_CV = 64 * MiB, WS_G = 66 * MiB, WS_HH = 67 * MiB, WS_HFB = 79 * MiB, WS_AB = 103 * MiB, WS_R = 127 * MiB, WS_END = 235 * MiB;
constexpr size_t PJ = 12 * MiB;
constexpr size_t R_MQ = 0 * PJ, R_MK = 1 * PJ, R_MV = 2 * PJ, R_MOS = 3 * PJ, R_DQ = 4 * PJ, R_DK = 5 * PJ, R_DV = 6 * PJ, R_GM = 7 * PJ, R_GD = 8 * PJ;
constexpr size_t R_U = 0, R_SLAB = 36 * MiB, R_P = 0;
static_assert(MISC_SW + (size_t)SW_END * 4 <= MiB, "MISC map");
constexpr size_t O_Y = 0, O_NEWK = 6291456, O_NEWV = 10485760, O_NEWC = 14680064, O_NEWN = 23068672, O_NEWM = 23101440, O_END = 23101568;
constexpr int CW_QUEUE = 64, CW_DBG = 128, CW_BAR = 4096, CW_CNT = 8192  , CW_FLG = 8192 + 512  , CW_DFT = 12288  , CW_CA = 16384  , CW_CB = 24576  , CW_CC = 28672  , CW_ROWSS = 65536  ;

__device__ __forceinline__ unsigned f2bf(float f) { unsigned u = __builtin_bit_cast(unsigned, f); return (u + 0x7fffu + ((u >> 16) & 1u)) >> 16; }
__device__ __forceinline__ unsigned pk2(float lo, float hi) { unsigned r; asm("v_cvt_pk_bf16_f32 %0, %1, %2" : "=v"(r) : "v"(lo), "v"(hi)); return r; }
__device__ __forceinline__ float bf2f(unsigned h) { return __builtin_bit_cast(float, h << 16); }
__device__ __forceinline__ float bflo(unsigned w) { return __builtin_bit_cast(float, w << 16); }
__device__ __forceinline__ float bfhi(unsigned w) { return __builtin_bit_cast(float, w & 0xffff0000u); }
__device__ __forceinline__ float wave_sum(float v) {
#pragma unroll
    for (int o = 1; o < 64; o <<= 1) v += __shfl_xor(v, o);
    return v;
}
__device__ __forceinline__ float sigmoidf_(float x) { return __builtin_amdgcn_rcpf(1.0f + __expf(-x)); }
__device__ __forceinline__ float siluf_(float x) { return x * __builtin_amdgcn_rcpf(1.0f + __expf(-x)); }
__device__ __forceinline__ float logsigmoidf_(float x) { return fminf(x, 0.f) - __logf(1.0f + __expf(-fabsf(x))); }

#define XB_TMO      128
#define XB_XCNT(j)  (256  + 64 * (j))
#define XB_XSUB(j)  (1280 + 64 * (j))
#define XB_XGEN(j)  (2304 + 64 * (j))
#define XB_TOP      3328
#define XB_TOPGEN   3392
#define XCD_BAR_WORDS 3456
#define XB_SPIN_CAP (1u << 18)
__device__ __forceinline__ unsigned xb_ld(unsigned* p)              { return __hip_atomic_load(p, __ATOMIC_RELAXED, __HIP_MEMORY_SCOPE_AGENT); }
__device__ __forceinline__ unsigned xb_add(unsigned* p, unsigned v) { return __hip_atomic_fetch_add(p, v, __ATOMIC_RELAXED, __HIP_MEMORY_SCOPE_AGENT); }
__device__ __forceinline__ unsigned xb_xcc_id() { return (unsigned)__builtin_amdgcn_s_getreg((3 << 11) | 20) & 0xFu; }
#define XB_SPIN(cond, bar) do { unsigned _sp = 0; while (cond) { __builtin_amdgcn_s_sleep(1); \
    if ((++_sp & 255u) == 0u) { if (xb_ld(&(bar)[XB_TMO])) break; if (_sp > XB_SPIN_CAP) { atomicAdd(&(bar)[XB_TMO], 1u); break; } } } } while (0)
struct XcdBarrier { unsigned* bar; unsigned x; volatile LAS unsigned* st; };
__device__ __forceinline__ XcdBarrier xcd_barrier_post(unsigned* bar, volatile LAS unsigned* st) {
    XcdBarrier b; b.bar = bar; b.x = xb_xcc_id(); b.st = st;
    if (threadIdx.x == 0) (void)xb_add(&bar[XB_XCNT(b.x)], 1u);
    return b;
}
__device__ __forceinline__ void xcd_barrier_complete(unsigned* bar, unsigned x, unsigned& nloc, unsigned& nx) {
    const unsigned G = gridDim.x * gridDim.y * gridDim.z;
    unsigned sum, cnt, mine, sp = 0u;
    for (;;) {
        sum = 0u; cnt = 0u; mine = 0u;
#pragma unroll
        for (unsigned j = 0; j < 16; ++j) { const unsigned c = xb_ld(&bar[XB_XCNT(j)]); sum += c; cnt += (c > 0u) ? 1u : 0u; mine = (j == x) ? c : mine; }
        if (sum == G) break;
        __builtin_amdgcn_s_sleep(1);
        if ((++sp & 255u) == 0u) { if (xb_ld(&bar[XB_TMO])) break; if (sp > XB_SPIN_CAP) { atomicAdd(&bar[XB_TMO], 1u); break; } }
    }
    nloc = mine > 0u ? mine : 1u; nx = cnt > 0u ? cnt : 1u;
}
__device__ __forceinline__ void xcd_barrier(const XcdBarrier& b, int tid) {
    asm volatile("s_waitcnt vmcnt(0)" ::: "memory");
    __syncthreads();
    if (tid == 0) {
        unsigned* bar = b.bar;
        __builtin_amdgcn_s_waitcnt(0);
        unsigned nloc = b.st[0], nx = b.st[1];
        if (nloc == 0u) { xcd_barrier_complete(bar, b.x, nloc, nx); b.st[0] = nloc; b.st[1] = nx; }
        const unsigned old = xb_add(&bar[XB_XSUB(b.x)], 1u);
        const unsigned gen = old / nloc;
        if (old + 1u == (gen + 1u) * nloc) {
            __builtin_amdgcn_fence(__ATOMIC_RELEASE, "agent");
            asm volatile("s_waitcnt vmcnt(0)" ::: "memory");
            const unsigned og = xb_add(&bar[XB_TOP], 1u);
            const unsigned tg = og / nx;
            if (og + 1u == (tg + 1u) * nx) xb_add(&bar[XB_TOPGEN], 1u);
            else XB_SPIN(xb_ld(&bar[XB_TOPGEN]) == tg, bar);
            __builtin_amdgcn_fence(__ATOMIC_ACQUIRE, "agent");
            xb_add(&bar[XB_XGEN(b.x)], 1u);
            asm volatile("s_waitcnt vmcnt(0)" ::: "memory");
        } else {
            XB_SPIN(xb_ld(&bar[XB_XGEN(b.x)]) == gen, bar);
            __builtin_amdgcn_fence(__ATOMIC_ACQUIRE, "agent");
            asm volatile("s_waitcnt vmcnt(0)" ::: "memory");
        }
    }
    __syncthreads();
}
namespace pg8 {
constexpr int BM = 256, BK = 64, HALF = 128, HTB = HALF * BK * 2  , STAGE_BYTES = 8 * HTB, NXCD = 8, WGM = 8;
__host__ __device__ __forceinline__ int lds_byte(int r, int c) { const int st = (r >> 4) * 2 + (c >> 5), rr = r & 15, cc = c & 31, ob = rr * 64 + cc * 2; return st * 1024 + (ob ^ (((ob >> 9) & 1) << 5)); }
__host__ __device__ __forceinline__ void stage_rc(int b, int& R, int& C) { const int st = b / 1024, sb = b % 1024, swz = sb ^ (((sb >> 9) & 1) << 5); R = (st >> 1) * 16 + swz / 64; C = (st & 1) * 32 + (swz % 64) / 2; }
__host__ __device__ __forceinline__ int perm32(int rho) { const int n = rho >> 4, i = rho & 15; return 8 * (i >> 2) + 4 * n + (i & 3); }

struct Unit { int pm, pn, z; };
struct Gemm { const bf16_t* A; const bf16_t* Bt; int lda, ldb, K; size_t zA, zB; };

struct Order {
    int nM, nN, nNz, nwg, G, c;
    __device__ __forceinline__ void init(int nM_, int nN_, int nZ_, int G_, int c_) { nM = nM_; nN = nN_; nNz = nN_ * nZ_; nwg = nM * nNz; G = G_; c = c_; }
    __device__ __forceinline__ bool next(int i, Unit& u) const {
        const long L = (long)i * G + c; if (L >= nwg) return false;
        int wgid = (int)L; { const int q = nwg / NXCD, r = nwg % NXCD, xcd = wgid % NXCD, off = wgid / NXCD; wgid = (xcd < r ? xcd * (q + 1) : r * (q + 1) + (xcd - r) * q) + off; }
        const int nig = WGM * nNz, gid = wgid / nig, fm = gid * WGM, gsz = (nM - fm) < WGM ? (nM - fm) : WGM;
        u.pm = fm + ((wgid % nig) % gsz); const int pnz = (wgid % nig) / gsz; u.z = pnz / nN; u.pn = pnz % nN; return true;
    }
};

struct OrderMixed { Order o;
    __device__ __forceinline__ bool next(int i, Unit& u) const {
        if (!o.next(i, u)) return false;
        if (u.pn < 36) u.pn = (int)((0x638251704ull >> (4 * (u.pn >> 2))) & 15ull) * 4 + (u.pn & 3);
        return true; }
};
__device__ __forceinline__ void st16_wt(void* p, u32x4 v) { asm volatile("global_store_dwordx4 %0, %1, off sc1\n\ts_nop 1" :: "v"(p), "v"(v) : "memory"); }
__device__ __forceinline__ void st16_wt(void* p, f32x4 v) { asm volatile("global_store_dwordx4 %0, %1, off sc1\n\ts_nop 1" :: "v"(p), "v"(v) : "memory"); }
__device__ __forceinline__ unsigned cvt_pk_bf16(float lo, float hi) { unsigned r; asm volatile("v_cvt_pk_bf16_f32 %0, %1, %2" : "=v"(r) : "v"(lo), "v"(hi)); return r; }


__device__ __forceinline__ int mods_index(int pm) { return pm < 16 ? 0 : 1 + ((pm - 16) >> 2); }
__device__ __forceinline__ int mods_row(int r) { return r < NCTX ? 0 : 1 + ((r - NCTX) >> 10); }

struct EpiSwiGLU {
    static constexpr bool PERM = true;
    bf16_t* U; const float* rowss; const float* sw;
    __device__ __forceinline__ void pre_issue(int, f32x4 (&)[3]) const {}
    __device__ __forceinline__ void pre_commit(int, const f32x4 (&)[3]) const {}
    template <int MT> __device__ __forceinline__ void operator()(const f32x4 (&acc)[2][2][MT][2], const Unit& u, int wr, int wc, int fr, int fq) const {
        constexpr int BMR = 64 * MT, HM = 32 * MT;
        const int row0 = u.pm * BMR + wr * (16 * MT) + fr, col0 = u.pn * 128 + wc * 32 + 8 * fq;
        const int mi0 = mods_row(u.pm * BMR), mi1 = mods_row(u.pm * BMR + BMR - 1), rb = mi1 == 2 ? NCTX + 1024 : NCTX;
        const float* s = sw + mi0 * 5632 + u.pn * BM + wc * 32 + 8 * fq;
        const f32x4 s10 = *(const f32x4*)s, s11 = *(const f32x4*)(s + 4), s30 = *(const f32x4*)(s + HALF), s31 = *(const f32x4*)(s + HALF + 4);
        f32x4 t10 = s10, t11 = s11, t30 = s30, t31 = s31;
        if (MT != 4) { const float* t = s + (mi1 - mi0) * 5632; t10 = *(const f32x4*)t; t11 = *(const f32x4*)(t + 4); t30 = *(const f32x4*)(t + HALF); t31 = *(const f32x4*)(t + HALF + 4); }
        float rsv[2][MT];
#pragma unroll
        for (int ai = 0; ai < 2; ++ai)
#pragma unroll
            for (int m = 0; m < MT; ++m) rsv[ai][m] = rowss[row0 + ai * HM + m * 16];
#define SWIGLU_ROWS(SEL) _Pragma("unroll") for (int ai = 0; ai < 2; ++ai) _Pragma("unroll") for (int m = 0; m < MT; ++m) { \
                const int r = row0 + ai * HM + m * 16; \
                const float rstd = rsqrtf(rsv[ai][m] * (1.0f / DM) + EPS); \
                bf16_t* rowp = U + (size_t)r * FF + col0; \
                const bool hi_ = (SEL) && r >= rb; \
                const f32x4 a10 = acc[ai][0][m][0] * rstd + (hi_ ? t10 : s10), a11 = acc[ai][0][m][1] * rstd + (hi_ ? t11 : s11), a30 = acc[ai][1][m][0] * rstd + (hi_ ? t30 : s30), a31 = acc[ai][1][m][1] * rstd + (hi_ ? t31 : s31); \
                f32x4 v0, v1; \
                _Pragma("unroll") for (int e = 0; e < 4; ++e) { v0[e] = siluf_(a10[e]) * a30[e]; v1[e] = siluf_(a11[e]) * a31[e]; } \
                u32x4 w; w.x = cvt_pk_bf16(v0[0], v0[1]); w.y = cvt_pk_bf16(v0[2], v0[3]); w.z = cvt_pk_bf16(v1[0], v1[1]); w.w = cvt_pk_bf16(v1[2], v1[3]); \
                *(u32x4*)rowp = w; }
        if (MT != 4 && mi0 != mi1) { SWIGLU_ROWS(true) } else { SWIGLU_ROWS(false) }
#undef SWIGLU_ROWS
    }
};
struct EpiProj {
    static constexpr bool PERM = false;
    unsigned char* R; float* newk; float* newv; const float* gq; const float* gk; LAS float* ropel; const float* rope; const float* rowss; const float* sw; const float* bgate; float* G;
    __device__ __forceinline__ void pre_issue(int tid, f32x4 (&r)[3]) const { r[0] = ((const f32x4*)rope)[tid]; }
    __device__ __forceinline__ void pre_commit(int tid, const f32x4 (&r)[3]) const { ((LAS f32x4*)ropel)[tid] = r[0]; }
    template <int MT> __device__ __forceinline__ void operator()(const f32x4 (&acc)[2][2][MT][2], const Unit& u, int wr, int wc, int fr, int fq) const {
        static_assert(MT == 4, "256-row tiles only");
        const int grp = u.pn >> 2, mi = mods_index(u.pm);
        const float* s = sw + mi * NWIN + u.pn * BM + wc * 32 + 4 * fq;
        if (u.pn == 36) {
            if (wc != 0) return;
            const f32x4 sg = *(const f32x4*)s + *(const f32x4*)(s + 16) + *(const f32x4*)(bgate + 4 * fq);
#pragma unroll
            for (int ai = 0; ai < 2; ++ai)
#pragma unroll
                for (int m = 0; m < 4; ++m) { const int r = u.pm * BM + ai * HALF + wr * 64 + m * 16 + fr;
                    const float rstd = rsqrtf(rowss[r] * (1.0f / DM) + EPS);
                    f32x4 x = (acc[ai][0][m][0] + acc[ai][0][m][1]) * rstd + sg;
                    if (fq & 1) {
#pragma unroll
                        for (int e = 0; e < 4; ++e) x[e] = logsigmoidf_(x[e]); }
                    *(f32x4*)(G + (size_t)r * 16 + 4 * fq) = x; }
            return;
        }
        f32x4 sv[2][2];
#pragma unroll
        for (int bj = 0; bj < 2; ++bj)
#pragma unroll
            for (int n = 0; n < 2; ++n) sv[bj][n] = *(const f32x4*)(s + bj * HALF + n * 16);
        bf16_t* dst = (bf16_t*)(R + (size_t)grp * PJ);
        const int cw = (u.pn & 3) * 256 + 64 * wc;
        float rsv[2][4];
#pragma unroll
        for (int ai = 0; ai < 2; ++ai)
#pragma unroll
            for (int m = 0; m < 4; ++m) rsv[ai][m] = rowss[u.pm * BM + ai * HALF + wr * 64 + m * 16 + fr];
        f32x4 gvv[2][2];
        if (grp == 4 || grp == 5) { const float* gw = (grp == 4) ? gq : gk;
#pragma unroll
            for (int bj = 0; bj < 2; ++bj)
#pragma unroll
                for (int n = 0; n < 2; ++n) gvv[bj][n] = *(const f32x4*)(gw + 32 * bj + 16 * n + 4 * fq); }

#pragma unroll
        for (int ai = 0; ai < 2; ++ai)
#pragma unroll
            for (int m = 0; m < 4; ++m) {
                const int r = u.pm * BM + ai * HALF + wr * 64 + m * 16 + fr;
                const float rs = rsqrtf(rsv[ai][m] * (1.0f / DM) + EPS);
                f32x4 v[2][2];
#pragma unroll
                for (int bj = 0; bj < 2; ++bj)
#pragma unroll
                    for (int n = 0; n < 2; ++n) v[bj][n] = acc[ai][bj][m][n] * rs + sv[bj][n];
                if (grp == 4 || grp == 5) {
                    const int cbase = cw + 4 * fq;
                    float ss = 0.f;
#pragma unroll
                    for (int bj = 0; bj < 2; ++bj)
#pragma unroll
                        for (int n = 0; n < 2; ++n) ss += (v[bj][n][0] * v[bj][n][0] + v[bj][n][1] * v[bj][n][1]) + (v[bj][n][2] * v[bj][n][2] + v[bj][n][3] * v[bj][n][3]);
                    ss += __shfl_xor(ss, 16); ss += __shfl_xor(ss, 32);
                    const float rstd = rsqrtf(ss * (1.0f / 64.0f) + EPS);
#pragma unroll
                    for (int bj = 0; bj < 2; ++bj)
#pragma unroll
                        for (int n = 0; n < 2; ++n) v[bj][n] = v[bj][n] * rstd * gvv[bj][n];
                    if (r >= NCTX) {
                        const int t = (r - NCTX) & 1023;
#pragma unroll
                        for (int bj = 0; bj < 2; ++bj) {
                            const int pos = bj ? (t & 63) : (t >> 6);
                            const f32x4 a = *(const LAS f32x4*)(ropel + (pos * 16 + 4 * fq) * 2), b = *(const LAS f32x4*)(ropel + (pos * 16 + 4 * fq) * 2 + 4);
                            const f32x4 cs = {a[0], a[2], b[0], b[2]}, sn = {a[1], a[3], b[1], b[3]};
                            const f32x4 x1 = v[bj][0], x2 = v[bj][1];
                            v[bj][0] = x1 * cs - x2 * sn; v[bj][1] = x2 * cs + x1 * sn;
                        }
                    } else if (grp == 5) {
#pragma unroll
                        for (int bj = 0; bj < 2; ++bj)
#pragma unroll
                            for (int n = 0; n < 2; ++n) __builtin_nontemporal_store(v[bj][n], (f32x4*)(newk + (size_t)r * DM + cbase + 32 * bj + 16 * n));
                    }
                    if (grp == 4) {
#pragma unroll
                        for (int bj = 0; bj < 2; ++bj)
#pragma unroll
                            for (int n = 0; n < 2; ++n) v[bj][n] = v[bj][n] * 0.18033688011112042f;
                    }
#pragma unroll
                    for (int bj = 0; bj < 2; ++bj)
#pragma unroll
                        for (int n = 0; n < 2; ++n) { u32x2 w; w.x = cvt_pk_bf16(v[bj][n][0], v[bj][n][1]); w.y = cvt_pk_bf16(v[bj][n][2], v[bj][n][3]);
                            *(u32x2*)(dst + (size_t)r * DM + cbase + 32 * bj + 16 * n) = w; }
                } else {
                    const int cbase = cw + 8 * fq;
                    if (grp == 0) {
#pragma unroll
                        for (int bj = 0; bj < 2; ++bj)
#pragma unroll
                            for (int n = 0; n < 2; ++n) v[bj][n] = v[bj][n] * 0.0625f;
                    } else if (grp >= 7) {
#pragma unroll
                        for (int bj = 0; bj < 2; ++bj)
#pragma unroll
                            for (int n = 0; n < 2; ++n)
#pragma unroll
                                for (int e = 0; e < 4; ++e) v[bj][n][e] = sigmoidf_(v[bj][n][e]);
                    } else if (grp == 6 && r < NCTX) {
#pragma unroll
                        for (int bj = 0; bj < 2; ++bj)
#pragma unroll
                            for (int n = 0; n < 2; ++n) __builtin_nontemporal_store(v[bj][n], (f32x4*)(newv + (size_t)r * DM + cbase + 32 * bj + 4 * n));
                    }
#pragma unroll
                    for (int bj = 0; bj < 2; ++bj) { u32x4 w; w.x = cvt_pk_bf16(v[bj][0][0], v[bj][0][1]); w.y = cvt_pk_bf16(v[bj][0][2], v[bj][0][3]); w.z = cvt_pk_bf16(v[bj][1][0], v[bj][1][1]); w.w = cvt_pk_bf16(v[bj][1][2], v[bj][1][3]);
                        *(u32x4*)(dst + (size_t)r * DM + cbase + 32 * bj) = w; }
                }
            }
    }
};
struct EpiBranch {
    static constexpr bool PERM = true;
    bf16_t* P; const unsigned char* R;
    __device__ __forceinline__ void pre_issue(int, f32x4 (&)[3]) const {}
    __device__ __forceinline__ void pre_commit(int, const f32x4 (&)[3]) const {}
    template <int MT> __device__ __forceinline__ void operator()(const f32x4 (&acc)[2][2][MT][2], const Unit& u, int wr, int wc, int fr, int fq) const {
        constexpr int BMR = 64 * MT, HM = 32 * MT;
        const bf16_t* sg = (const bf16_t*)(R + (u.z ? R_GD : R_GM));
        const int row0 = u.pm * BMR + wr * (16 * MT) + fr, col0 = u.pn * BM + wc * 32 + 8 * fq;
        u32x4 gg[2][MT][2];
#pragma unroll
        for (int ai = 0; ai < 2; ++ai)
#pragma unroll
            for (int m = 0; m < MT; ++m)
#pragma unroll
                for (int bj = 0; bj < 2; ++bj) gg[ai][m][bj] = *(const u32x4*)(sg + (size_t)(row0 + ai * HM + m * 16) * DM + col0 + bj * HALF);
#pragma unroll
        for (int ai = 0; ai < 2; ++ai) {
#pragma unroll
            for (int m = 0; m < MT; ++m) { const int r = row0 + ai * HM + m * 16;
#pragma unroll
                for (int bj = 0; bj < 2; ++bj) { const int c = col0 + bj * HALF;
                    const u32x4 g = gg[ai][m][bj];
                    const f32x4 a0 = acc[ai][bj][m][0], a1 = acc[ai][bj][m][1];
                    u32x4 w; w.x = cvt_pk_bf16(a0[0] * bflo(g.x), a0[1] * bfhi(g.x)); w.y = cvt_pk_bf16(a0[2] * bflo(g.y), a0[3] * bfhi(g.y));
                    w.z = cvt_pk_bf16(a1[0] * bflo(g.z), a1[1] * bfhi(g.z)); w.w = cvt_pk_bf16(a1[2] * bflo(g.w), a1[3] * bfhi(g.w));
                    st16_wt(P + (size_t)r * 2048 + (size_t)u.z * 1024 + c, w); } } }
    }
};
__device__ __forceinline__ void store_sc1(float* p, f32x4 v) { asm volatile("global_store_dwordx4 %0, %1, off sc1\n\ts_nop 1" :: "v"(p), "v"(v) : "memory"); }
template <int MODE> struct EpiCombine {
    static constexpr bool PERM = false;
    float* slab; unsigned* flg; const float* xp; const float* xs; float* Y; bf16_t* HH; float* rowss; LAS float* gl;
    static constexpr int GIDX = MODE == 0 ? 2 : (MODE == 1 ? 5 : 8); static constexpr float GSC = MODE == 1 ? 1.0f : 0.5f;
    const float* mods; const float* gs;
    __device__ __forceinline__ void pre_issue(int tid, f32x4 (&r)[3]) const {
#pragma unroll
        for (int j = 0; j < 3; ++j) { const int q = tid + 512 * j, q2 = q < 768 ? q : q - 768, mi = q2 >> 8, c = (q2 & 255) * 4;
            if (q < 768) r[j] = *(const f32x4*)(mods + (mi * NMOD + GIDX) * DM + c) * GSC; else if (MODE != 2) r[j] = *(const f32x4*)(gs + ((MODE + 1) * 3 + mi) * DM + c); }
    }
    __device__ __forceinline__ void pre_commit(int tid, const f32x4 (&r)[3]) const {
#pragma unroll
        for (int j = 0; j < 3; ++j) { const int q = tid + 512 * j; if (q < 768 || MODE != 2) ((LAS f32x4*)gl)[q] = r[j]; }
    }
    template <int AI, int MT> __device__ __forceinline__ void half(const f32x4 (&acc)[2][2][MT][2], const Unit& u, int wr, int wc, int fr, int fq) const {
        constexpr int BMR = 64 * MT, HM = 32 * MT;
        const int tile = u.pm * 4 + u.pn, wid = wr * 4 + wc, lane = fq * 16 + fr, tid = wid * 64 + lane;
        unsigned char* mine = (unsigned char*)slab + ((size_t)(tile * 2 + AI) * 8 + wid) * 8192 + lane * 16;
#pragma unroll
        for (int m = 0; m < MT; ++m)
#pragma unroll
            for (int bj = 0; bj < 2; ++bj) { const f32x4 a0 = acc[1 - AI][bj][m][0], a1 = acc[1 - AI][bj][m][1];
                u32x4 w; w.x = cvt_pk_bf16(a0[0], a0[1]); w.y = cvt_pk_bf16(a0[2], a0[3]); w.z = cvt_pk_bf16(a1[0], a1[1]); w.w = cvt_pk_bf16(a1[2], a1[3]);
                st16_wt(mine + (m * 2 + bj) * 1024, w); }
        asm volatile("s_waitcnt vmcnt(0)" ::: "memory"); __builtin_amdgcn_s_barrier(); asm volatile("" ::: "memory");
        if (tid == 0) __hip_atomic_store(flg + tile * 2 + AI, 1u, __ATOMIC_RELAXED, __HIP_MEMORY_SCOPE_AGENT);
        asm volatile("" ::: "memory");
        const int col0 = u.pn * BM + wc * 32 + 4 * fq;
        const int rbase = u.pm * BMR + AI * HM + wr * (16 * MT) + fr;
        if constexpr (MT == 4) {
        if (tid == 0) { unsigned sp = 0u;
            while (__hip_atomic_load(flg + tile * 2 + (1 - AI), __ATOMIC_RELAXED, __HIP_MEMORY_SCOPE_AGENT) == 0u) { __builtin_amdgcn_s_sleep(2); if (++sp > (1u << 22)) break; }
            __builtin_amdgcn_fence(__ATOMIC_ACQUIRE, "agent"); }
        asm volatile("s_waitcnt vmcnt(0) lgkmcnt(0)" ::: "memory"); __builtin_amdgcn_s_barrier(); asm volatile("" ::: "memory");
        const unsigned char* theirs = (const unsigned char*)slab + ((size_t)(tile * 2 + (1 - AI)) * 8 + wid) * 8192 + lane * 16;
#pragma unroll
        for (int m = 0; m < MT; ++m) { const int r = rbase + m * 16; const size_t off = (size_t)r * DM + col0;
            const float* xres = MODE == 0 ? (r < NCTX ? xp + off : xs + (off - (size_t)NCTX * DM)) : Y + off;
            const LAS float* gp = gl + mods_row(r) * DM + col0;
            f32x4 T[2][2], X[2][2];
            u32x4 tw[2];
#pragma unroll
            for (int bj = 0; bj < 2; ++bj) { tw[bj] = *(const u32x4*)(theirs + (m * 2 + bj) * 1024);
#pragma unroll
                for (int n = 0; n < 2; ++n) X[bj][n] = (MODE == 0) ? __builtin_nontemporal_load((const f32x4*)(xres + bj * HALF + n * 16)) : *(const f32x4*)(xres + bj * HALF + n * 16); }
#pragma unroll
            for (int bj = 0; bj < 2; ++bj) { T[bj][0] = (f32x4){bflo(tw[bj].x), bfhi(tw[bj].x), bflo(tw[bj].y), bfhi(tw[bj].y)}; T[bj][1] = (f32x4){bflo(tw[bj].z), bfhi(tw[bj].z), bflo(tw[bj].w), bfhi(tw[bj].w)}; }
            float ss = 0.f;
#pragma unroll
            for (int bj = 0; bj < 2; ++bj)
#pragma unroll
                for (int n = 0; n < 2; ++n) { const int o = bj * HALF + n * 16;
                    const f32x4 v = acc[AI][bj][m][n] + T[bj][n];
                    const f32x4 xn = X[bj][n] + *(const LAS f32x4*)(gp + o) * v;
                    if (MODE == 2) __builtin_nontemporal_store(xn, (f32x4*)(Y + off + o)); else *(f32x4*)(Y + off + o) = xn;
                    if (MODE != 2) { ss += (xn[0] * xn[0] + xn[1] * xn[1]) + (xn[2] * xn[2] + xn[3] * xn[3]);
                        const f32x4 h = xn * *(const LAS f32x4*)(gp + 3 * DM + o); u32x2 w; w.x = cvt_pk_bf16(h[0], h[1]); w.y = cvt_pk_bf16(h[2], h[3]);
                        *(u32x2*)(HH + off + o) = w; } }
            if (MODE != 2) { ss += __shfl_xor(ss, 16); ss += __shfl_xor(ss, 32); if (fq == 0) atomicAdd(rowss + r, ss); }
        }
        } else {
        f32x4 X[MT][2][2];
#pragma unroll
        for (int m = 0; m < MT; ++m) { const int r = rbase + m * 16; const size_t off = (size_t)r * DM + col0;
            const float* xres = MODE == 0 ? (r < NCTX ? xp + off : xs + (off - (size_t)NCTX * DM)) : Y + off;
#pragma unroll
            for (int bj = 0; bj < 2; ++bj)
#pragma unroll
                for (int n = 0; n < 2; ++n) X[m][bj][n] = (MODE == 0) ? __builtin_nontemporal_load((const f32x4*)(xres + bj * HALF + n * 16)) : *(const f32x4*)(xres + bj * HALF + n * 16); }
        asm volatile("" ::: "memory");
        if (tid == 0) { unsigned sp = 0u;
            while (__hip_atomic_load(flg + tile * 2 + (1 - AI), __ATOMIC_RELAXED, __HIP_MEMORY_SCOPE_AGENT) == 0u) { __builtin_amdgcn_s_sleep(2); if (++sp > (1u << 22)) break; }
            __builtin_amdgcn_fence(__ATOMIC_ACQUIRE, "agent"); }
        asm volatile("s_waitcnt vmcnt(0) lgkmcnt(0)" ::: "memory"); __builtin_amdgcn_s_barrier(); asm volatile("" ::: "memory");
        const unsigned char* theirs = (const unsigned char*)slab + ((size_t)(tile * 2 + (1 - AI)) * 8 + wid) * 8192 + lane * 16;
        u32x4 tw[MT][2];
#pragma unroll
        for (int m = 0; m < MT; ++m)
#pragma unroll
            for (int bj = 0; bj < 2; ++bj) tw[m][bj] = *(const u32x4*)(theirs + (m * 2 + bj) * 1024);
#pragma unroll
        for (int m = 0; m < MT; ++m) { const int r = rbase + m * 16; const size_t off = (size_t)r * DM + col0;
            const LAS float* gp = gl + mods_row(r) * DM + col0;
            f32x4 T[2][2];
#pragma unroll
            for (int bj = 0; bj < 2; ++bj) { T[bj][0] = (f32x4){bflo(tw[m][bj].x), bfhi(tw[m][bj].x), bflo(tw[m][bj].y), bfhi(tw[m][bj].y)}; T[bj][1] = (f32x4){bflo(tw[m][bj].z), bfhi(tw[m][bj].z), bflo(tw[m][bj].w), bfhi(tw[m][bj].w)}; }
            float ss = 0.f;
#pragma unroll
            for (int bj = 0; bj < 2; ++bj)
#pragma unroll
                for (int n = 0; n < 2; ++n) { const int o = bj * HALF + n * 16;
                    const f32x4 v = acc[AI][bj][m][n] + T[bj][n];
                    const f32x4 xn = X[m][bj][n] + *(const LAS f32x4*)(gp + o) * v;
                    if (MODE == 2) __builtin_nontemporal_store(xn, (f32x4*)(Y + off + o)); else *(f32x4*)(Y + off + o) = xn;
                    if (MODE != 2) { ss += (xn[0] * xn[0] + xn[1] * xn[1]) + (xn[2] * xn[2] + xn[3] * xn[3]);
                        const f32x4 h = xn * *(const LAS f32x4*)(gp + 3 * DM + o); u32x2 w; w.x = cvt_pk_bf16(h[0], h[1]); w.y = cvt_pk_bf16(h[2], h[3]);
                        *(u32x2*)(HH + off + o) = w; } }
            if (MODE != 2) { ss += __shfl_xor(ss, 16); ss += __shfl_xor(ss, 32); if (fq == 0) atomicAdd(rowss + r, ss); }
        }
        }
    }
    template <int MT> __device__ __forceinline__ void operator()(const f32x4 (&acc)[2][2][MT][2], const Unit& u, int wr, int wc, int fr, int fq) const {
        if (u.z == 0) half<0, MT>(acc, u, wr, wc, fr, fq); else half<1, MT>(acc, u, wr, wc, fr, fq);
    }
};

template <class Epi, bool ALIGN_EPI, int MT = 4, class Sched = Order>
__device__ __forceinline__ void gemm_phase(LAS unsigned char* lds, const Gemm g, const Sched& S, const Epi& E, int tid_in) {
    int tid = tid_in; asm volatile("" : "+v"(tid));
    const int wid = __builtin_amdgcn_readfirstlane(tid >> 6), lane = tid & 63, wr = wid >> 2, wc = wid & 3, fr = lane & 15, fq = lane >> 4;
    const int K = g.K, nt = K / BK;
    unsigned voffA[2], voffB[2];
#pragma unroll
    for (int i = 0; i < 2; ++i) { int R, C; stage_rc(tid * 16 + i * 8192, R, C); const int Rb = Epi::PERM ? ((R & ~31) + perm32(R & 31)) : R;
        const int Ra = R < 32 * MT ? R : R - 32 * MT;
        voffA[i] = (unsigned)(Ra * g.lda + C) * 2u; voffB[i] = (unsigned)(Rb * g.ldb + C) * 2u; }
    const size_t kstep = (size_t)(BK * 2);
    const size_t hstepA = (size_t)(32 * MT) * g.lda * 2, hstepB = (size_t)HALF * g.ldb * 2;
    const unsigned ldsw = (unsigned)wid * 1024u;
    const int aoff = lds_byte(wr * (16 * MT) + fr, fq * 8), boff = lds_byte(wc * 32 + fr, fq * 8);
#define PG8_SA(b, h) (((b) * 2 + (h)) * HTB)
#define PG8_SB(b, h) ((4 + (b) * 2 + (h)) * HTB)
#define PG8_STAGE(bufoff, gbase, voff) do { _Pragma("unroll") for (int _i = 0; _i < 2; ++_i) \
        __builtin_amdgcn_global_load_lds((const unsigned*)((const char*)(gbase) + (voff)[_i]), (LAS unsigned*)(lds + (bufoff) + ldsw + _i * 8192), 16, 0, 0); } while (0)
#define PG8_LDA(dst, b, h) do { _Pragma("unroll") for (int m = 0; m < MT; ++m) _Pragma("unroll") for (int k = 0; k < 2; ++k) dst[m][k] = *(const LAS bf16x8*)(lds + PG8_SA(b, h) + aoff + m * 2048 + k * 1024); } while (0)
#define PG8_LDB(dst, b, h) do { _Pragma("unroll") for (int n = 0; n < 2; ++n) _Pragma("unroll") for (int k = 0; k < 2; ++k) dst[n][k] = *(const LAS bf16x8*)(lds + PG8_SB(b, h) + boff + n * 2048 + k * 1024); } while (0)
#define PG8_MMA(ai, bj, At, Bt) do { __builtin_amdgcn_s_setprio(1); _Pragma("unroll") for (int m = 0; m < MT; ++m) _Pragma("unroll") for (int n = 0; n < 2; ++n) _Pragma("unroll") for (int k = 0; k < 2; ++k) \
        acc[ai][bj][m][n] = __builtin_amdgcn_mfma_f32_16x16x32_bf16(Bt[n][k], At[m][k], acc[ai][bj][m][n], 0, 0, 0); __builtin_amdgcn_s_setprio(0); } while (0)
#define PG8_WAIT_V(n) asm volatile("s_waitcnt vmcnt(" #n ")" ::: "memory")
#define PG8_WAIT_L(n) asm volatile("s_waitcnt lgkmcnt(" #n ")" ::: "memory")
#define PG8_BAR __builtin_amdgcn_s_barrier()
#define PG8_SCHED __builtin_amdgcn_sched_barrier(0)
#define PG8_UA(u) ((const char*)g.A + ((size_t)(u).pm * (64 * MT) * g.lda + (size_t)(u).z * g.zA) * 2)
#define PG8_UB(u) ((const char*)g.Bt + ((size_t)(u).pn * BM * g.ldb + (size_t)(u).z * g.zB) * 2)
    Unit cur, nxt; int ui = 0;
    if (!S.next(0, cur)) return;
    f32x4 acc[2][2][MT][2];
#pragma unroll
    for (int a = 0; a < 2; ++a)
#pragma unroll
        for (int b = 0; b < 2; ++b)
#pragma unroll
            for (int m = 0; m < MT; ++m)
#pragma unroll
                for (int n = 0; n < 2; ++n) acc[a][b][m][n] = (f32x4){0.f, 0.f, 0.f, 0.f};
    bf16x8 At[MT][2], B0[2][2], B1[2][2];
    const char* cA = PG8_UA(cur); const char* cB = PG8_UB(cur);
    f32x4 pre[3]; E.pre_issue(tid, pre);
    PG8_STAGE(PG8_SB(0, 0), cB, voffB); PG8_STAGE(PG8_SB(0, 1), cB + hstepB, voffB); PG8_STAGE(PG8_SA(0, 0), cA, voffA); PG8_STAGE(PG8_SA(0, 1), cA + hstepA, voffA);
    E.pre_commit(tid, pre);
    if (wr == 1) PG8_BAR;
    PG8_WAIT_V(2); PG8_BAR;
    PG8_STAGE(PG8_SB(1, 0), cB + kstep, voffB); PG8_STAGE(PG8_SA(1, 0), cA + kstep, voffA); PG8_STAGE(PG8_SB(1, 1), cB + hstepB + kstep, voffB);
    PG8_WAIT_V(6); PG8_BAR;
    for (;;) {
        const bool has_next = S.next(ui + 1, nxt);
        const char* nA = has_next ? PG8_UA(nxt) : cA; const char* nB = has_next ? PG8_UB(nxt) : cB;
        for (int t = 0; t < nt; t += 2) {
            const bool last = (t == nt - 2);
            const char* a1 = cA + (size_t)(t + 1) * kstep;
            const char* a2 = last ? nA : cA + (size_t)(t + 2) * kstep; const char* b2 = last ? nB : cB + (size_t)(t + 2) * kstep;
            const char* a3 = a2 + kstep; const char* b3 = b2 + kstep;
            PG8_LDB(B0, 0, 0); PG8_LDB(B1, 0, 1); PG8_SCHED; PG8_LDA(At, 0, 0); PG8_STAGE(PG8_SA(1, 1), a1 + hstepA, voffA);
            PG8_WAIT_V(8); PG8_WAIT_L(0); PG8_BAR; PG8_MMA(0, 0, At, B0); PG8_MMA(0, 1, At, B1); PG8_BAR; PG8_SCHED;
            PG8_LDA(At, 0, 1); PG8_STAGE(PG8_SB(0, 0), b2, voffB); PG8_STAGE(PG8_SB(0, 1), b2 + hstepB, voffB); PG8_STAGE(PG8_SA(0, 0), a2, voffA);
            PG8_WAIT_V(8); PG8_WAIT_L(0); PG8_BAR; PG8_MMA(1, 0, At, B0); PG8_MMA(1, 1, At, B1); PG8_BAR; PG8_SCHED;
            PG8_LDB(B0, 1, 0); PG8_LDB(B1, 1, 1); PG8_SCHED; PG8_LDA(At, 1, 0); PG8_STAGE(PG8_SA(0, 1), a2 + hstepA, voffA);
            PG8_WAIT_V(8); PG8_WAIT_L(0); PG8_BAR; PG8_MMA(0, 0, At, B0); PG8_MMA(0, 1, At, B1); PG8_BAR; PG8_SCHED;
            PG8_LDA(At, 1, 1); PG8_STAGE(PG8_SB(1, 0), b3, voffB); PG8_STAGE(PG8_SB(1, 1), b3 + hstepB, voffB); PG8_STAGE(PG8_SA(1, 0), a3, voffA);
            PG8_WAIT_V(8); PG8_WAIT_L(0); PG8_BAR; PG8_MMA(1, 0, At, B0); PG8_MMA(1, 1, At, B1); PG8_BAR; PG8_SCHED;
        }
        if constexpr (ALIGN_EPI) { if (wr == 0) PG8_BAR; }
        E.template operator()<MT>(acc, cur, wr, wc, fr, fq);
        if (!has_next) break;
#pragma unroll
        for (int a = 0; a < 2; ++a)
#pragma unroll
            for (int b = 0; b < 2; ++b)
#pragma unroll
                for (int m = 0; m < MT; ++m)
#pragma unroll
                    for (int n = 0; n < 2; ++n) acc[a][b][m][n] = (f32x4){0.f, 0.f, 0.f, 0.f};
        cur = nxt; cA = nA; cB = nB; ++ui;
        if constexpr (ALIGN_EPI) { if (wr == 1) PG8_BAR; }
    }
    PG8_WAIT_V(0);
    if constexpr (!ALIGN_EPI) { if (wr == 0) PG8_BAR; }
    PG8_BAR;
#undef PG8_SA
#undef PG8_SB
#undef PG8_STAGE
#undef PG8_LDA
#undef PG8_LDB
#undef PG8_MMA
#undef PG8_WAIT_V
#undef PG8_WAIT_L
#undef PG8_BAR
#undef PG8_SCHED
#undef PG8_UA
#undef PG8_UB
}
}
constexpr int NWAVES = 8;
constexpr int LDS_BYTES = 163840;
constexpr int MISC_OFF = LDS_BYTES - 512;
struct Args { const float* in[31]; float* out; unsigned char* ws; int ph_lo, ph_hi; };
enum { I_XP = 0, I_XS, I_C, I_CK, I_CV, I_SC, I_SN, I_SM, I_CCTX, I_WADA, I_BADA, I_GNORM, I_F1W1, I_F1W3, I_F1W2, I_F2W1, I_F2W3, I_F2W2, I_WIN, I_BGATE, I_GQN, I_GKN,
       I_LQ1, I_LK1, I_LQ2, I_LK2, I_GSUB, I_GMH, I_WBRM, I_WBRD, I_WOUT };
#define LDS_WAIT() asm volatile("s_waitcnt lgkmcnt(0)" ::: "memory")
typedef const unsigned char __attribute__((address_space(4)))* KP;
#define AIN(i) (*(const float* const __attribute__((address_space(4)))*)(kp + 8 * (i)))
#define AOUT (*(float* const __attribute__((address_space(4)))*)(kp + 248))
#define AWS (*(unsigned char* const __attribute__((address_space(4)))*)(kp + 256))
static_assert(sizeof(Args) == 272, "Args layout");

struct TrItem { const float* W; bf16_t* WT; float* swo; int ldw, ncol0, k0, ldk, drow0, swn; bool rowperm; };
__device__ __forceinline__ TrItem tr_decode(KP kp, int set, int it) {
    constexpr int I_UP = 16 * 88, I_IN = 16 * 288, I_DN = 44 * 32, I_SQ = 16 * 32;
    float* swb = (float*)(AWS + WS_MISC + MISC_SW);
    TrItem t; t.swo = nullptr; t.swn = 0; t.rowperm = false;
    int r = it;
    if (set == 1) {
        if (r < I_IN) {
            const int kb = r / 288, nb = r % 288, f0 = 32 * nb, src = f0 < 4096 ? f0 : f0 + 16, fw = f0 & 255, grp = f0 >> 10;
            t.W = AIN(I_WIN); t.ldw = DIN; t.ncol0 = src; t.k0 = 64 * kb; t.WT = (bf16_t*)(AWS + WS_WIN); t.ldk = DM; t.drow0 = (f0 & ~255) + 128 * ((fw >> 5) & 1) + 32 * (fw >> 6);
            t.rowperm = !(grp == 4 || grp == 5); t.swo = swb + SW_C; t.swn = NWIN; return t; }
        r -= I_IN;
        { const int kb = r / 32, nb = r % 32;
          t.W = AIN(I_F1W2); t.ldw = DM; t.ncol0 = 32 * nb; t.k0 = 64 * kb; t.WT = (bf16_t*)(AWS + WS_W2A); t.ldk = FF; t.drow0 = 32 * nb; return t; }
    }
    if (r < 2 * I_UP) {
        const int which = r / I_UP; r -= which * I_UP;
        const int kb = r / 88, nb = r % 88, n0 = 32 * nb;
        t.W = AIN(set == 0 ? (which == 0 ? I_F1W1 : I_F1W3) : (which == 0 ? I_F2W1 : I_F2W3)); t.ldw = FF; t.ncol0 = n0; t.k0 = 64 * kb;
        t.WT = (bf16_t*)(AWS + (set ? WS_W13B : WS_W13A)); t.ldk = DM; t.drow0 = 256 * (n0 >> 7) + (which ? 128 : 0) + (n0 & 127);
        if (set == 2) { t.swo = swb + SW_F; t.swn = 5632; }
        return t; }
    r -= 2 * I_UP;
    if (r < I_DN) {
        const int kb = r / 32, nb = r % 32;
        t.W = AIN(I_F2W2); t.ldw = DM; t.ncol0 = 32 * nb; t.k0 = 64 * kb; t.WT = (bf16_t*)(AWS + WS_W2B); t.ldk = FF; t.drow0 = 32 * nb; return t; }
    r -= I_DN;
    { const int which = r / I_SQ; r -= which * I_SQ; const int kb = r / 32, nb = r % 32;
      t.W = AIN(which == 0 ? I_WBRM : which == 1 ? I_WBRD : I_WOUT); t.ldw = DM; t.ncol0 = 32 * nb; t.k0 = 64 * kb; t.WT = (bf16_t*)(AWS + (which == 2 ? WS_WOUT : WS_WBR)); t.ldk = DM;
      t.drow0 = (which == 1 ? 1024 : 0) + 32 * nb; return t; }
}
__device__ __forceinline__ void tr_load(const TrItem& t, float (&wreg)[32], int lane) {
#pragma unroll
    for (int i = 0; i < 32; ++i) wreg[i] = __builtin_nontemporal_load(&t.W[(size_t)(t.k0 + 2 * i + (lane >> 5)) * t.ldw + t.ncol0 + (lane & 31)]);
}
__device__ __forceinline__ void p0_transposes(KP kp, LAS unsigned char* lds, int wave, int lane, int gw, int NGW, int set, bool sw_on = true) {
    LAS float* scr = (LAS float*)(lds + wave * 16384);
    constexpr int I_UP = 16 * 88, I_DN = 44 * 32, I_IN = 16 * 288, I_SQ = 16 * 32;
    const int nitems = set == 0 ? 2 * I_UP : set == 1 ? I_IN + I_DN : 2 * I_UP + I_DN + 3 * I_SQ;
    LAS float* shl = (LAS float*)(lds + 131072);
    if (set != 0) { const float* mods = (const float*)(AWS + WS_MISC + MISC_MODS);
        for (int i = wave * 64 + lane; i < 3 * DM; i += NWAVES * 64) shl[i] = mods[((i >> 10) * NMOD + 3 * set) * DM + (i & 1023)];
        __syncthreads(); }
    if (gw >= nitems) return;
    float wreg[32];
    TrItem t = tr_decode(kp, set, gw);
    tr_load(t, wreg, lane);
    for (int it = gw; it < nitems; it += NGW) {
#pragma unroll
        for (int i = 0; i < 32; ++i) scr[(2 * i + (lane >> 5)) * 33 + (lane & 31)] = wreg[i];
        LDS_WAIT(); asm volatile("" ::: "memory");
        const TrItem c = t;
        if (it + NGW < nitems) { t = tr_decode(kp, set, it + NGW); tr_load(t, wreg, lane); }
        if (c.swo && sw_on) {
            const int n = lane & 31, kh = lane >> 5;
            float d0 = 0.f, d1 = 0.f, d2 = 0.f;
#pragma unroll 2
            for (int kk = 0; kk < 32; kk += 4) { const int k = kh * 32 + kk;
                const f32x4 h0 = *(const LAS f32x4*)(shl + c.k0 + k), h1 = *(const LAS f32x4*)(shl + DM + c.k0 + k), h2 = *(const LAS f32x4*)(shl + 2 * DM + c.k0 + k);
#pragma unroll
                for (int e = 0; e < 4; ++e) { const float w = scr[(k + e) * 33 + n]; d0 += w * h0[e]; d1 += w * h1[e]; d2 += w * h2[e]; } }
            d0 += __shfl_xor(d0, 32); d1 += __shfl_xor(d1, 32); d2 += __shfl_xor(d2, 32);
            if (lane < 32) { const int nd = c.rowperm ? 16 * ((n >> 2) & 1) + 4 * (n >> 3) + (n & 3) : n;
                atomicAdd(c.swo + c.drow0 + nd, d0); atomicAdd(c.swo + c.swn + c.drow0 + nd, d1); atomicAdd(c.swo + 2 * c.swn + c.drow0 + nd, d2); }
        }
        const int cc = lane & 7;
#pragma unroll
        for (int j = 0; j < 4; ++j) { const int n = (lane >> 3) + 8 * j; const LAS float* sp = scr + (8 * cc) * 33 + n;
            u32x4 o; o.x = pk2(sp[0 * 33], sp[1 * 33]); o.y = pk2(sp[2 * 33], sp[3 * 33]); o.z = pk2(sp[4 * 33], sp[5 * 33]); o.w = pk2(sp[6 * 33], sp[7 * 33]);
            const int nd = c.rowperm ? 16 * ((n >> 2) & 1) + 4 * (n >> 3) + (n & 3) : n;
            *(u32x4*)(c.WT + (size_t)(c.drow0 + nd) * c.ldk + c.k0 + 8 * cc) = o; }
        LDS_WAIT(); asm volatile("" ::: "memory");
    }
}
__device__ __forceinline__ void p0_misc(KP kp, int gt, int NGT) {
    {
      for (int i0 = gt; i0 < 262144; i0 += 3 * NGT) {
          f32x4 vk[3], vv[3];
#pragma unroll
          for (int q = 0; q < 3; ++q) { const int i = i0 + q * NGT; if (i < 262144) { vk[q] = __builtin_nontemporal_load((const f32x4*)AIN(I_CK) + i); vv[q] = __builtin_nontemporal_load((const f32x4*)AIN(I_CV) + i); } }
#pragma unroll
          for (int q = 0; q < 3; ++q) { const int i = i0 + q * NGT; if (i < 262144) {
              u32x2 ok, ov; ok.x = pk2(vk[q][0], vk[q][1]); ok.y = pk2(vk[q][2], vk[q][3]); ov.x = pk2(vv[q][0], vv[q][1]); ov.y = pk2(vv[q][2], vv[q][3]);
              ((u32x2*)(AWS + WS_CK))[i] = ok; ((u32x2*)(AWS + WS_CV))[i] = ov; } } }
      bf16_t* wg = (bf16_t*)(AWS + WS_WIN) + (size_t)9216 * DM;
      for (int i = gt; i < 32 * 1024; i += NGT) { const int p_ = i >> 10, k = i & 1023; const float w = AIN(I_WIN)[(size_t)k * DIN + 4096 + (p_ & 15)]; const unsigned hi = f2bf(w);
          wg[i] = (bf16_t)(p_ < 16 ? hi : f2bf(w - bf2f(hi)));
          if (p_ < 16) {
              const float* mods = (const float*)(AWS + WS_MISC + MISC_MODS); float* swc = (float*)(AWS + WS_MISC + MISC_SW) + SW_C;
#pragma unroll
              for (int mi = 0; mi < 3; ++mi) { const float d = wave_sum(w * mods[(mi * NMOD + 3) * DM + k]); if ((i & 63) == 0) atomicAdd(swc + mi * NWIN + 9216 + p_, d); } } }
      for (int i = gt; i < 224 * 1024 / 8; i += NGT) ((u32x4*)(wg + 32 * 1024))[i] = (u32x4){0u, 0u, 0u, 0u};
      float* rope = (float*)(AWS + WS_MISC + MISC_ROPE);
      for (int i = gt; i < 1024; i += NGT) { const int pos = i >> 4, fi = i & 15;
          double th = 1.0; for (int q = 0; q < fi; ++q) th *= 0.56234132519034908;
          double sn = 0.0, cs = 0.0, term = 1.0;
          for (int q = 0; q < 24; ++q) { if (q & 1) sn += ((q >> 1) & 1) ? -term : term; else cs += ((q >> 1) & 1) ? -term : term; term *= th / (double)(q + 1); }
          double rc = 1.0, rs = 0.0, bc = cs, bs = sn;
          for (int p = pos; p > 0; p >>= 1) { if (p & 1) { const double t = rc * bc - rs * bs; rs = rc * bs + rs * bc; rc = t; } const double t2 = bc * bc - bs * bs; bs = 2.0 * bc * bs; bc = t2; }
          rope[2 * i] = (float)rc; rope[2 * i + 1] = (float)rs; }
    }
}
__device__ __forceinline__ void p0_prologue(KP kp, LAS unsigned char* lds, int tid, int wave, int lane, int vcu, int G) {
    LAS float* sc = (LAS float*)(lds + 65536);
    LAS float* part = (LAS float*)(lds + 65536 + 24576);
    for (int i = tid; i < 3 * 1024; i += 512) { const int v = i >> 10, k = i & 1023; const float x = v == 0 ? AIN(I_CCTX)[k] : AIN(I_C)[(v - 1) * 1024 + k]; sc[i] = siluf_(x); }
    if (tid < 64) { sc[3072 + tid] = 0.f; sc[3072 + 1024 + tid] = 0.f; sc[3072 + 2048 + tid] = 0.f; }
    { float* swz = (float*)(AWS + WS_MISC + MISC_SW); for (int i = SW_C + vcu * 512 + tid; i < SW_END; i += G * 512) swz[i] = 0.f; }
    __syncthreads();
    if (wave < 4) p0_transposes(kp, lds, wave, lane, vcu * 4 + wave, G * 4, 0);
    for (int cb = blockIdx.x; cb < 256; cb += G) {
        if (wave >= 4) {
            const int w4 = wave - 4, rsub = lane / 9, c4 = lane % 9;
            f32x4 acc[3]; acc[0] = acc[1] = acc[2] = (f32x4){0.f, 0.f, 0.f, 0.f};
            const char* wbase = (const char*)(AIN(I_WADA) + (size_t)(256 * w4) * (NMOD * DM) + 36 * cb);
            unsigned woff = (unsigned)((rsub * (NMOD * DM) + 4 * c4) * 4); asm volatile("" : "+v"(woff));
            unsigned wlast = rsub < 4 ? woff : (unsigned)(((255 - 252) * (NMOD * DM) + 4 * c4) * 4); asm volatile("" : "+v"(wlast));
            const LAS float* slast = rsub < 4 ? sc + 256 * w4 + rsub + 252 : sc + 3072;
            if (lane < 63) {
#define MODS_BATCH(half) do { f32x4 w[13]; \
                    _Pragma("unroll") for (int it = 0; it < 13; ++it) { const int j = it + 13 * (half); if (j <= 36) \
                        w[it] = __builtin_nontemporal_load((const f32x4*)(wbase + (j < 36 ? woff : wlast) + (unsigned)(7 * (j < 36 ? j : 36) * (NMOD * DM * 4)))); } \
                    _Pragma("unroll") for (int it = 0; it < 13; ++it) { const int j = it + 13 * (half); const LAS float* s_ = j < 36 ? sc + 256 * w4 + rsub + 7 * j : slast; \
                        if (j <= 36) { acc[0] += w[it] * s_[0]; acc[1] += w[it] * s_[1024]; acc[2] += w[it] * s_[2048]; } } } while (0)
                MODS_BATCH(0); __builtin_amdgcn_sched_barrier(0); MODS_BATCH(1); __builtin_amdgcn_sched_barrier(0); MODS_BATCH(2);
#undef MODS_BATCH
#pragma unroll
                for (int v = 0; v < 3; ++v)
#pragma unroll
                    for (int e = 0; e < 4; ++e) part[(w4 * 7 + rsub) * 108 + v * 36 + 4 * c4 + e] = acc[v][e];
            }
        }
        __syncthreads();
        if (tid < 108) { float s_ = 0.f; for (int p_ = 0; p_ < 28; ++p_) s_ += part[p_ * 108 + tid];
            const int v = tid / 36, col = 36 * cb + tid % 36;
            ((float*)(AWS + WS_MISC + MISC_MODS))[v * (NMOD * DM) + col] = s_ + AIN(I_BADA)[col]; }
        __syncthreads();
    }
}
__device__ __forceinline__ void p1_pass(KP kp, int tid, int wave, int lane, int vcu, int G) {
    const float* mods = (const float*)(AWS + WS_MISC + MISC_MODS);
    bf16_t* HH = (bf16_t*)(AWS + WS_HH);
    float* rowss = (float*)(AWS + WS_CTL) + CW_ROWSS;
    const int gw = vcu * NWAVES + wave, NGW = G * NWAVES;
    f32x4 gn[4];
#pragma unroll
    for (int j = 0; j < 4; ++j) gn[j] = ((const f32x4*)AIN(I_GNORM))[lane + 64 * j];
    const bf16_t* Wt = (const bf16_t*)(AWS + WS_W13A); float* swo = (float*)(AWS + WS_MISC + MISC_SW) + SW_A; constexpr int NR = 5632;
    f32x4 sh[3][4];
#pragma unroll
    for (int mi = 0; mi < 3; ++mi) { const float* p_ = mods + (mi * NMOD) * DM + 8 * lane; sh[mi][0] = *(const f32x4*)p_; sh[mi][1] = *(const f32x4*)(p_ + 4); sh[mi][2] = *(const f32x4*)(p_ + 512); sh[mi][3] = *(const f32x4*)(p_ + 516); }
    u32x4 wa[3], wb[3]; int rowb = gw;
#define P1_SW_LOAD() _Pragma("unroll") for (int q = 0; q < 3; ++q) { const int row = rowb + q * NGW; wa[q] = (u32x4){0u, 0u, 0u, 0u}; wb[q] = wa[q]; \
        if (row < NR) { wa[q] = *(const u32x4*)(Wt + (size_t)row * DM + 8 * lane); wb[q] = *(const u32x4*)(Wt + (size_t)row * DM + 512 + 8 * lane); } }
    P1_SW_LOAD()
    for (int m0 = gw; m0 < MROWS; m0 += 3 * NGW) {
        f32x4 v[3][4], sc[3][4];
#pragma unroll
        for (int q = 0; q < 3; ++q) { const int m = m0 + q * NGW; if (m < MROWS) { const float* src = m < NCTX ? AIN(I_XP) + (size_t)m * DM : AIN(I_XS) + (size_t)(m - NCTX) * DM;
            const int mi = m < NCTX ? 0 : 1 + ((m - NCTX) >> 10);
#pragma unroll
            for (int j = 0; j < 4; ++j) { v[q][j] = ((const f32x4*)src)[lane + 64 * j]; sc[q][j] = ((const f32x4*)(mods + (mi * NMOD + 1) * DM))[lane + 64 * j]; } } }
#pragma unroll
        for (int q = 0; q < 3; ++q) { const int m = m0 + q * NGW; if (m < MROWS) {
            float ss = 0.f;
#pragma unroll
            for (int j = 0; j < 4; ++j) { ss += (v[q][j][0] * v[q][j][0] + v[q][j][1] * v[q][j][1]) + (v[q][j][2] * v[q][j][2] + v[q][j][3] * v[q][j][3]);
                const f32x4 h = v[q][j] * (gn[j] * (sc[q][j] + 1.0f));
                u32x2 o; o.x = pk2(h[0], h[1]); o.y = pk2(h[2], h[3]);
                ((u32x2*)(HH + (size_t)m * DM))[lane + 64 * j] = o; }
            ss = wave_sum(ss); if (lane == 0) rowss[m] = ss; } }
    }
    if (gw == 0) { const float q1 = wave_sum(AIN(I_LQ1)[lane] * AIN(I_LK1)[lane]), q2 = wave_sum(AIN(I_LQ2)[lane] * AIN(I_LK2)[lane]); if (lane == 0) *(float*)(AWS + WS_MISC + MISC_LAM) = __expf(q1) - __expf(q2) + 0.2f; }
    { float* gs = (float*)(AWS + WS_MISC + MISC_GS);
      for (int i = vcu * 512 + tid; i < 9 * DM; i += G * 512) { const int k = i / (3 * DM), mi = (i / DM) % 3, c = i % DM; gs[i] = AIN(I_GNORM)[k * DM + c] * (1.0f + mods[(mi * NMOD + 3 * k + 1) * DM + c]); } }
    for (;;) {
#pragma unroll
        for (int q = 0; q < 3; ++q) { const int row = rowb + q * NGW;
            const f32x4 w0 = {bflo(wa[q].x), bfhi(wa[q].x), bflo(wa[q].y), bfhi(wa[q].y)}, w1 = {bflo(wa[q].z), bfhi(wa[q].z), bflo(wa[q].w), bfhi(wa[q].w)}, w2 = {bflo(wb[q].x), bfhi(wb[q].x), bflo(wb[q].y), bfhi(wb[q].y)}, w3 = {bflo(wb[q].z), bfhi(wb[q].z), bflo(wb[q].w), bfhi(wb[q].w)};
            float d[3];
#pragma unroll
            for (int mi = 0; mi < 3; ++mi) { const f32x4 t = sh[mi][0] * w0 + sh[mi][1] * w1 + sh[mi][2] * w2 + sh[mi][3] * w3; d[mi] = wave_sum((t[0] + t[1]) + (t[2] + t[3])); }
            if (lane == 0 && row < NR) { swo[row] = d[0]; swo[NR + row] = d[1]; swo[2 * NR + row] = d[2]; } }
        rowb += 3 * NGW; if (rowb >= NR) break;
        P1_SW_LOAD()
    }
#undef P1_SW_LOAD
}
__device__ __forceinline__ void st8_wt(void* p, u32x2 v) { asm volatile("global_store_dwordx2 %0, %1, off sc1" :: "v"(p), "v"(v) : "memory"); }
__device__ __forceinline__ void hm_rows(KP kp, int pm, int pn, int z, int tid, int wave, int lane) {
    const bf16_t* HF = (const bf16_t*)(AWS + WS_HFB); const bf16_t* HB = HF + (size_t)MROWS * DM;
    const bf16_t* MOS = (const bf16_t*)(AWS + WS_R + R_MOS);
    bf16_t* AB = (bf16_t*)(AWS + WS_AB);
    unsigned* flg = (unsigned*)(AWS + WS_CTL) + CW_DFT + pm * 8;
    f32x4 gm[4];
#pragma unroll
    for (int j = 0; j < 4; ++j) gm[j] = ((const f32x4*)AIN(I_GMH))[lane + 64 * j];
    const int r0 = pm * 192 + (pn * 2 + z) * 24 + wave * 3;
    u32x2 f[3][4], b[3][4], o[3][4];
#pragma unroll
    for (int q = 0; q < 3; ++q) { const int m = r0 + q;
#pragma unroll
        for (int j = 0; j < 4; ++j) { f[q][j] = ((const u32x2*)(HF + (size_t)m * DM))[lane + 64 * j]; b[q][j] = ((const u32x2*)(HB + (size_t)m * DM))[lane + 64 * j]; o[q][j] = ((const u32x2*)(MOS + (size_t)m * DM))[lane + 64 * j]; } }
#pragma unroll
    for (int q = 0; q < 3; ++q) { const int m = r0 + q;
#pragma unroll
        for (int j = 0; j < 4; ++j) {
            f32x4 s = {bflo(f[q][j].x) + bflo(b[q][j].x), bfhi(f[q][j].x) + bfhi(b[q][j].x), bflo(f[q][j].y) + bflo(b[q][j].y), bfhi(f[q][j].y) + bfhi(b[q][j].y)};
            const float ss = wave_sum((s[0] * s[0] + s[1] * s[1]) + (s[2] * s[2] + s[3] * s[3]));
            const float rstd = rsqrtf(ss * (1.0f / 256.0f) + EPS);
            s = s * rstd * gm[j] * (f32x4){sigmoidf_(bflo(o[q][j].x)), sigmoidf_(bfhi(o[q][j].x)), sigmoidf_(bflo(o[q][j].y)), sigmoidf_(bfhi(o[q][j].y))};
            u32x2 w; w.x = pk2(s[0], s[1]); w.y = pk2(s[2], s[3]);
            st8_wt((u32x2*)(AB + (size_t)m * 2048) + lane + 64 * j, w); } }
    asm volatile("s_waitcnt vmcnt(0)" ::: "memory"); __syncthreads();
    if (tid < 64) {
        if (tid == 0) __hip_atomic_store(flg + pn * 2 + z, 1u, __ATOMIC_RELAXED, __HIP_MEMORY_SCOPE_AGENT);
        if (z == 0) { unsigned sp = 0u;
            for (;;) { const unsigned v = __hip_atomic_load(flg + (lane & 7), __ATOMIC_RELAXED, __HIP_MEMORY_SCOPE_AGENT);
                if (__builtin_amdgcn_ballot_w64(v == 0u) == 0ull || ++sp > (1u << 22)) break;
                __builtin_amdgcn_s_sleep(2); }
            __builtin_amdgcn_fence(__ATOMIC_ACQUIRE, "agent"); } }
    asm volatile("s_waitcnt vmcnt(0) lgkmcnt(0)" ::: "memory"); __syncthreads();
}
#define MFMA16(a, b, c) __builtin_amdgcn_mfma_f32_16x16x32_bf16((a), (b), (c), 0, 0, 0)
typedef short v4i16_t __attribute__((ext_vector_type(4)));
__device__ __forceinline__ s16x4 tr_read(LAS unsigned char* p) { return __builtin_bit_cast(s16x4, __builtin_amdgcn_ds_read_tr16_b64_v4i16((LAS v4i16_t*)p)); }
__device__ __forceinline__ bf16x8 cat8(s16x4 a, s16x4 b) { return (bf16x8){a[0], a[1], a[2], a[3], b[0], b[1], b[2], b[3]}; }
__device__ __forceinline__ bf16x8 pack8(f32x4 a, f32x4 b) { u32x4 w; w.x = pg8::cvt_pk_bf16(a[0], a[1]); w.y = pg8::cvt_pk_bf16(a[2], a[3]); w.z = pg8::cvt_pk_bf16(b[0], b[1]); w.w = pg8::cvt_pk_bf16(b[2], b[3]); return __builtin_bit_cast(bf16x8, w); }

__device__ __forceinline__ float max3f(float a, float b, float c) { float r; asm("v_max3_f32 %0, %1, %2, %3" : "=v"(r) : "v"(a), "v"(b), "v"(c)); return r; }
__device__ __forceinline__ float xlane_max(float x) { x = fmaxf(x, __shfl_xor(x, 16)); return fmaxf(x, __shfl_xor(x, 32)); }
__device__ __forceinline__ float xlane_sum(float x) { x += __shfl_xor(x, 16); return x + __shfl_xor(x, 32); }
constexpr int AT_ROW = 288, AT_TILE = 64 * AT_ROW, AT_BUF = 2 * AT_TILE;
__device__ __forceinline__ void attn_unit(KP kp, LAS unsigned char* lds, int lat, int b, int h, int qb, float lam, int tid, int wave, int lane) {
    const unsigned char* R = AWS + WS_R;
    const bf16_t* DQ = (const bf16_t*)(R + R_DQ); const bf16_t* DK = (const bf16_t*)(R + R_DK); const bf16_t* DV = (const bf16_t*)(R + R_DV);
    const bf16_t* CK = (const bf16_t*)(AWS + WS_CK); const bf16_t* CV = (const bf16_t*)(AWS + WS_CV);
    const int r0 = lat ? NCTX + b * 1024 : b * 256, nown = lat ? 1024 : 256, ntile = lat ? 24 : 4;
    const int fr = lane & 15, g = lane >> 4;
    const int qrow = r0 + qb * 128 + wave * 16 + fr;
    bf16x8 qf[2][2];
    { const char* qb_ = (const char*)(DQ + (size_t)(r0 + qb * 128 + wave * 16) * DM + h * 128); const unsigned qo_ = (unsigned)(fr * (DM * 2) + g * 16);
      asm volatile("global_load_dwordx4 %0, %4, %5\n\tglobal_load_dwordx4 %1, %4, %5 offset:64\n\tglobal_load_dwordx4 %2, %4, %5 offset:128\n\tglobal_load_dwordx4 %3, %4, %5 offset:192"
          : "=&v"(qf[0][0]), "=&v"(qf[0][1]), "=&v"(qf[1][0]), "=&v"(qf[1][1]) : "v"(qo_), "s"(qb_) : "memory"); }
    float mx[2] = {0.f, 0.f}, ls[2] = {0.f, 0.f};
    f32x4 O[2][8];
#pragma unroll
    for (int c = 0; c < 2; ++c)
#pragma unroll
        for (int vb = 0; vb < 8; ++vb) O[c][vb] = (f32x4){0.f, 0.f, 0.f, 0.f};
    u32x4 kreg[2][2], vreg[2][2];
    const int key0 = tid >> 4, ch = tid & 15;
    const unsigned lo_at = (unsigned)(key0 * (DM * 2) + ch * 16), lo_at2 = lo_at + (unsigned)(32 * DM * 2);
#define AT_LOAD(kt, set) do { const int kb_ = (kt) * 64; const char* ks_; const char* vs_; \
        if (kb_ < nown) { ks_ = (const char*)(DK + (size_t)(r0 + kb_) * DM + h * 128); vs_ = (const char*)(DV + (size_t)(r0 + kb_) * DM + h * 128); } \
        else { ks_ = (const char*)(CK + (size_t)(b * 512 + kb_ - nown) * DM + h * 128); vs_ = (const char*)(CV + (size_t)(b * 512 + kb_ - nown) * DM + h * 128); } \
        asm volatile("global_load_dwordx4 %0, %4, %6\n\tglobal_load_dwordx4 %1, %4, %7\n\tglobal_load_dwordx4 %2, %5, %6\n\tglobal_load_dwordx4 %3, %5, %7" \
            : "=&v"(kreg[set][0]), "=&v"(vreg[set][0]), "=&v"(kreg[set][1]), "=&v"(vreg[set][1]) : "v"(lo_at), "v"(lo_at2), "s"(ks_), "s"(vs_) : "memory"); } while (0)
#define AT_WAIT(n, set) asm volatile("s_waitcnt vmcnt(" #n ")" : "+v"(kreg[set][0]), "+v"(vreg[set][0]), "+v"(kreg[set][1]), "+v"(vreg[set][1]) :: "memory")
#define AT_STORE(buf, set) do { _Pragma("unroll") for (int i_ = 0; i_ < 2; ++i_) { \
        *(LAS u32x4*)(lds + (buf) * AT_BUF + (key0 + 32 * i_) * AT_ROW + ch * 16) = kreg[set][i_]; *(LAS u32x4*)(lds + (buf) * AT_BUF + AT_TILE + (key0 + 32 * i_) * AT_ROW + ch * 16) = vreg[set][i_]; } } while (0)
    __syncthreads();
    AT_LOAD(0, 0); AT_LOAD(1, 1);
    AT_WAIT(4, 0); asm volatile("" : "+v"(qf[0][0]), "+v"(qf[0][1]), "+v"(qf[1][0]), "+v"(qf[1][1]));
    AT_STORE(0, 0); AT_LOAD(2, 0);
    __syncthreads();
    for (int kt0 = 0; kt0 < ntile; kt0 += 2)
#pragma unroll
    for (int ku = 0; ku < 2; ++ku) { const int kt = kt0 + ku;
        LAS unsigned char* Ks = lds + (kt & 1) * AT_BUF; LAS unsigned char* Vs = Ks + AT_TILE;
        f32x4 S[2][4];
#pragma unroll
        for (int c = 0; c < 2; ++c)
#pragma unroll
            for (int j = 0; j < 4; ++j) { const float ni = -mx[c]; S[c][j] = (f32x4){ni, ni, ni, ni};
#pragma unroll
                for (int s = 0; s < 2; ++s) { const bf16x8 kf = *(const LAS bf16x8*)(Ks + (16 * j + fr) * AT_ROW + (c * 64 + s * 32 + g * 8) * 2); S[c][j] = MFMA16(kf, qf[c][s], S[c][j]); } }
        float tl[2];
#pragma unroll
        for (int c = 0; c < 2; ++c) { float t = max3f(S[c][0][0], S[c][0][1], S[c][0][2]); t = max3f(t, S[c][0][3], S[c][1][0]); t = max3f(t, S[c][1][1], S[c][1][2]); t = max3f(t, S[c][1][3], S[c][2][0]);
            t = max3f(t, S[c][2][1], S[c][2][2]); t = max3f(t, S[c][2][3], S[c][3][0]); t = max3f(t, S[c][3][1], S[c][3][2]); tl[c] = max3f(t, S[c][3][3], t); }
        const bool first = (kt == 0);
        if (first || __builtin_amdgcn_ballot_w64((tl[0] > 8.f) || (tl[1] > 8.f)) != 0ull) {
#pragma unroll
            for (int c = 0; c < 2; ++c) { const float tmf = xlane_max(tl[c]); const float d = first ? tmf : fmaxf(tmf, 0.f);
                if (!first) { const float alpha = __builtin_amdgcn_exp2f(-d); ls[c] *= alpha;
#pragma unroll
                    for (int vb = 0; vb < 8; ++vb) O[c][vb] = O[c][vb] * alpha; }
                mx[c] += d;
#pragma unroll
                for (int j = 0; j < 4; ++j) S[c][j] = S[c][j] - d; }
        }
        bf16x8 pb[2][2];
#pragma unroll
        for (int c = 0; c < 2; ++c) { float rs = 0.f;
#pragma unroll
            for (int j = 0; j < 4; ++j)
#pragma unroll
                for (int e = 0; e < 4; ++e) { S[c][j][e] = __builtin_amdgcn_exp2f(S[c][j][e]); rs += S[c][j][e]; }
            ls[c] += rs;
            pb[c][0] = pack8(S[c][0], S[c][1]); pb[c][1] = pack8(S[c][2], S[c][3]); }
#pragma unroll
        for (int b2 = 0; b2 < 2; ++b2) {
            LAS unsigned char* vp = Vs + (32 * b2 + 4 * g + (fr >> 2)) * AT_ROW + (4 * (fr & 3)) * 2;
#pragma unroll
            for (int vb = 0; vb < 8; ++vb) { const bf16x8 vf = cat8(tr_read(vp + vb * 32), tr_read(vp + 16 * AT_ROW + vb * 32));
                O[0][vb] = MFMA16(vf, pb[0][b2], O[0][vb]); O[1][vb] = MFMA16(vf, pb[1][b2], O[1][vb]); }
        }
        if (kt + 1 < ntile) { if (kt + 2 < ntile) AT_WAIT(4, (ku + 1) & 1); else AT_WAIT(0, (ku + 1) & 1); AT_STORE((kt + 1) & 1, (ku + 1) & 1); }
        __syncthreads();
        if (kt + 3 < ntile) AT_LOAD(kt + 3, (ku + 1) & 1);
    }
#undef AT_LOAD
#undef AT_WAIT
#undef AT_STORE
    float inv[2];
#pragma unroll
    for (int c = 0; c < 2; ++c) inv[c] = __builtin_amdgcn_rcpf(xlane_sum(ls[c]));
    const float i0 = inv[0], i1 = lam * inv[1];
    float ss = 0.f;
#pragma unroll
    for (int vb = 0; vb < 8; ++vb) { O[0][vb] = O[0][vb] * i0 - O[1][vb] * i1; ss += (O[0][vb][0] * O[0][vb][0] + O[0][vb][1] * O[0][vb][1]) + (O[0][vb][2] * O[0][vb][2] + O[0][vb][3] * O[0][vb][3]); }
    ss = xlane_sum(ss);
    const float rstd = rsqrtf(ss * (1.0f / 128.0f) + EPS) * 0.8f;
    bf16_t* AB = (bf16_t*)(AWS + WS_AB);
#pragma unroll
    for (int vb = 0; vb < 8; ++vb) O[1][vb] = *(const f32x4*)(AIN(I_GSUB) + 16 * vb + 4 * g);
#pragma unroll
    for (int vb = 0; vb < 8; ++vb) { const f32x4 o = O[0][vb] * rstd * O[1][vb];
        u32x2 w; w.x = pk2(o[0], o[1]); w.y = pk2(o[2], o[3]);
        *(u32x2*)(AB + (size_t)qrow * 2048 + 1024 + h * 128 + 16 * vb + 4 * g) = w; }
}

constexpr int ML_KROW = 544, ML_VROW = 144;
constexpr int ML_K = 0, ML_V = 128 * ML_KROW  , ML_VW = ML_V + 128 * ML_VROW  , ML_CT = ML_VW + 128 * ML_VROW  , ML_B = ML_CT + 64 * ML_KROW  , ML_E = ML_B + 4096, ML_PM = ML_E + 4096, ML_N = ML_PM + 4096, ML_W = ML_N + 1024, ML_END = ML_W + 512;
static_assert(ML_END <= MISC_OFF, "mLSTM LDS map");
__device__ __forceinline__ void mlstm_unit(KP kp, LAS unsigned char* lds, int lat, int b, int h, int dir, int vs, int tid, int wave, int lane) {
    const unsigned char* R = AWS + WS_R;
    const bf16_t* MQ = (const bf16_t*)(R + R_MQ); const bf16_t* MK = (const bf16_t*)(R + R_MK); const bf16_t* MV = (const bf16_t*)(R + R_MV);
    const float* Gt = (const float*)(AWS + WS_G);
    bf16_t* HO = (bf16_t*)(AWS + WS_HFB) + (size_t)dir * MROWS * DM;
    const int r0 = lat ? NCTX + b * 1024 : b * 256, nc = lat ? 8 : 2;
    const int fr = lane & 15, g = lane >> 4;
    LAS float* Bc = (LAS float*)(lds + ML_B); LAS float* Ec = (LAS float*)(lds + ML_E); LAS float* Pm = (LAS float*)(lds + ML_PM);
    LAS float* Nv = (LAS float*)(lds + ML_N); LAS float* Wv = (LAS float*)(lds + ML_W);
    u32x4 kpre[8], vpre[2]; bf16x8 qf[8];
    const int krow0 = tid >> 5, kch = tid & 31, vrow0 = tid >> 3, vch = tid & 7;
#define ML_OROW(cb_, row_) (r0 + (dir ? (cb_) + 127 - (row_) : (cb_) + (row_)))
#define ML_PREFETCH_KV(k_) do { const int cb_ = 128 * (dir ? nc - 1 - (k_) : (k_)); \
        const char* kb_ = (const char*)MK + ((size_t)(r0 + cb_) * DM + h * 256) * 2; const char* vb_ = (const char*)MV + ((size_t)(r0 + cb_) * DM + h * 256 + vs * 64) * 2; \
        unsigned ko_ = (unsigned)((dir ? 127 - krow0 : krow0) * (DM * 2) + kch * 16), vo_ = (unsigned)((dir ? 127 - vrow0 : vrow0) * (DM * 2) + vch * 16); asm volatile("" : "+v"(ko_), "+v"(vo_)); \
        _Pragma("unroll") for (int i_ = 0; i_ < 8; ++i_) kpre[i_] = *(const u32x4*)(kb_ + (dir ? ko_ - (unsigned)(i_ * 16 * DM * 2) : ko_ + (unsigned)(i_ * 16 * DM * 2))); \
        _Pragma("unroll") for (int i_ = 0; i_ < 2; ++i_) vpre[i_] = *(const u32x4*)(vb_ + (dir ? vo_ - (unsigned)(i_ * 64 * DM * 2) : vo_ + (unsigned)(i_ * 64 * DM * 2))); } while (0)
#define ML_PREFETCH_Q(k_) do { const int cb_ = 128 * (dir ? nc - 1 - (k_) : (k_)); \
        const char* qb_ = (const char*)MQ + ((size_t)(r0 + cb_) * DM + h * 256) * 2; unsigned qo_ = (unsigned)((dir ? 127 - (16 * wave + fr) : 16 * wave + fr) * (DM * 2) + g * 16); asm volatile("" : "+v"(qo_)); \
        _Pragma("unroll") for (int ks_ = 0; ks_ < 8; ++ks_) qf[ks_] = *(const bf16x8*)(qb_ + qo_ + ks_ * 64); } while (0)
    ML_PREFETCH_KV(0); ML_PREFETCH_Q(0);
    __syncthreads();
    if (wave < nc) {
        const int k = wave, cb = 128 * (dir ? nc - 1 - k : k), t0 = 2 * lane;
        const int rowA = ML_OROW(cb, t0), rowB = ML_OROW(cb, t0 + 1);
        constexpr float L2E = 1.4426950408889634f;
        const float iA = Gt[(size_t)rowA * 16 + dir * 8 + h] * L2E, fA = Gt[(size_t)rowA * 16 + dir * 8 + 4 + h] * L2E;
        const float iB = Gt[(size_t)rowB * 16 + dir * 8 + h] * L2E, fB = Gt[(size_t)rowB * 16 + dir * 8 + 4 + h] * L2E;
        const float s1 = fA + fB; float incl = s1;
#pragma unroll
        for (int o = 1; o < 64; o <<= 1) { const float t = __shfl_up(incl, o); if (lane >= o) incl += t; }
        const float excl = incl - s1, bA = excl + fA, bB = excl + s1, eA = iA - bA, eB = iB - bB;
        const float p1 = fmaxf(eA, eB); float im = p1;
#pragma unroll
        for (int o = 1; o < 64; o <<= 1) { const float t = __shfl_up(im, o); if (lane >= o) im = fmaxf(im, t); }
        float ex = __shfl_up(im, 1); if (lane == 0) ex = -INFINITY;
        Bc[k * 128 + t0] = bA; Bc[k * 128 + t0 + 1] = bB; Ec[k * 128 + t0] = eA; Ec[k * 128 + t0 + 1] = eB;
        Pm[k * 128 + t0] = fmaxf(ex, eA); Pm[k * 128 + t0 + 1] = fmaxf(ex, p1);
    }
    const size_t sidx = (size_t)((b * 2 + dir) * 4 + h);
    float m_prev = lat ? AIN(I_SM)[sidx] * 1.4426950408889634f : 0.f;
    f32x4 Cacc[2][4], nacc[2];
    unsigned coff = (unsigned)((4 * g * 256 + fr) * 4); asm volatile("" : "+v"(coff));
#pragma unroll
    for (int dt = 0; dt < 2; ++dt) {
        nacc[dt] = (f32x4){0.f, 0.f, 0.f, 0.f};
        if (lat && fr == 0) nacc[dt] = *(const f32x4*)(AIN(I_SN) + sidx * 256 + 32 * wave + 16 * dt + 4 * g);
#pragma unroll
        for (int vt = 0; vt < 4; ++vt) {
            if (lat) {
                const char* cbase = (const char*)(AIN(I_SC) + (sidx * 256 + 32 * wave) * 256 + vs * 64);
#pragma unroll
                for (int e = 0; e < 4; ++e) Cacc[dt][vt][e] = *(const float*)(cbase + coff + (unsigned)(((16 * dt + e) * 256 + 16 * vt) * 4));
            } else Cacc[dt][vt] = (f32x4){0.f, 0.f, 0.f, 0.f};
        }
    }
    __syncthreads();
    for (int k = 0; k < nc; ++k) {
        const int cb = 128 * (dir ? nc - 1 - k : k);
        const int tq = 16 * wave + fr, qrow = ML_OROW(cb, tq);
        if (k > 0) __syncthreads();
        const float Mlast = fmaxf(m_prev, Pm[k * 128 + 127]), m_new = Bc[k * 128 + 127] + Mlast, decay = __builtin_amdgcn_exp2f(m_prev - Mlast);
#pragma unroll
        for (int i = 0; i < 8; ++i) *(LAS u32x4*)(lds + ML_K + (krow0 + 16 * i) * ML_KROW + kch * 16) = kpre[i];
#pragma unroll
        for (int i = 0; i < 2; ++i) { const int row = vrow0 + 64 * i; const float w = __builtin_amdgcn_exp2f(Ec[k * 128 + row] - Mlast);
            *(LAS u32x4*)(lds + ML_V + row * ML_VROW + vch * 16) = vpre[i];
            u32x4 x = vpre[i]; x.x = pg8::cvt_pk_bf16(bflo(x.x) * w, bfhi(x.x) * w); x.y = pg8::cvt_pk_bf16(bflo(x.y) * w, bfhi(x.y) * w); x.z = pg8::cvt_pk_bf16(bflo(x.z) * w, bfhi(x.z) * w); x.w = pg8::cvt_pk_bf16(bflo(x.w) * w, bfhi(x.w) * w);
            *(LAS u32x4*)(lds + ML_VW + row * ML_VROW + vch * 16) = x;
            if (vch == 0) Wv[row] = w; }
        const bool zero_state = !lat && k == 0;
        if (!zero_state) {
#pragma unroll
        for (int dt = 0; dt < 2; ++dt) {
#pragma unroll
            for (int vt = 0; vt < 4; ++vt) { u32x2 w; w.x = pg8::cvt_pk_bf16(Cacc[dt][vt][0], Cacc[dt][vt][1]); w.y = pg8::cvt_pk_bf16(Cacc[dt][vt][2], Cacc[dt][vt][3]);
                *(LAS u32x2*)(lds + ML_CT + (16 * vt + fr) * ML_KROW + (32 * wave + 16 * dt + 4 * g) * 2) = w; }
            if (fr == 0) *(LAS f32x4*)(Nv + 32 * wave + 16 * dt + 4 * g) = nacc[dt];
        } }
        if (k + 1 < nc) ML_PREFETCH_KV(k + 1);
        __syncthreads();
        const float Mt = fmaxf(m_prev, Pm[k * 128 + tq]), inter = __builtin_amdgcn_exp2f(m_prev - Mt);
        int wv_ = wave; asm volatile("" : "+s"(wv_));
        f32x4 S[8];
        float rsum = 0.f;
#pragma unroll
        for (int st = 0; st < 8; ++st) {
            S[st] = (f32x4){0.f, 0.f, 0.f, 0.f};
            if (st <= wv_) {
#pragma unroll
                for (int ks = 0; ks < 8; ++ks) { const bf16x8 kf = *(const LAS bf16x8*)(lds + ML_K + (16 * st + fr) * ML_KROW + (32 * ks + 8 * g) * 2); S[st] = MFMA16(kf, qf[ks], S[st]); }
                const f32x4 ev = *(const LAS f32x4*)(Ec + k * 128 + 16 * st + 4 * g);
#pragma unroll
                for (int e = 0; e < 4; ++e) { float wgt = __builtin_amdgcn_exp2f(ev[e] - Mt); if (st == wv_) wgt = (4 * g + e <= fr) ? wgt : 0.f; S[st][e] *= wgt; rsum += S[st][e]; }
                __builtin_amdgcn_sched_barrier(0);
            }
        }
        rsum = xlane_sum(rsum);
        bf16x8 pb[4];
#pragma unroll
        for (int b2 = 0; b2 < 4; ++b2) pb[b2] = pack8(S[2 * b2], S[2 * b2 + 1]);
        float qn = 0.f;
        if (!zero_state) {
#pragma unroll
        for (int ks = 0; ks < 8; ++ks) { const u32x4 qw = __builtin_bit_cast(u32x4, qf[ks]); const f32x4 n0 = *(const LAS f32x4*)(Nv + 32 * ks + 8 * g), n1 = *(const LAS f32x4*)(Nv + 32 * ks + 8 * g + 4);
            qn += (bflo(qw.x) * n0[0] + bfhi(qw.x) * n0[1]) + (bflo(qw.y) * n0[2] + bfhi(qw.y) * n0[3]) + (bflo(qw.z) * n1[0] + bfhi(qw.z) * n1[1]) + (bflo(qw.w) * n1[2] + bfhi(qw.w) * n1[3]); }
        qn = xlane_sum(qn); }
        f32x4 N1[4], N2[4];
#pragma unroll
        for (int vt = 0; vt < 4; ++vt) { N1[vt] = (f32x4){0.f, 0.f, 0.f, 0.f}; N2[vt] = (f32x4){0.f, 0.f, 0.f, 0.f}; }
#pragma unroll
        for (int b2 = 0; b2 < 4; ++b2) {
            if (2 * b2 <= wv_) {
                LAS unsigned char* vp = lds + ML_V + (32 * b2 + 4 * g + (fr >> 2)) * ML_VROW + (4 * (fr & 3)) * 2;
#pragma unroll
                for (int vt = 0; vt < 4; ++vt) { const bf16x8 vf = cat8(tr_read(vp + vt * 32), tr_read(vp + 16 * ML_VROW + vt * 32)); N1[vt] = MFMA16(vf, pb[b2], N1[vt]); }
            }
        }
        if (!zero_state) {
#pragma unroll
        for (int ks = 0; ks < 8; ++ks)
#pragma unroll
            for (int vt = 0; vt < 4; ++vt) { const bf16x8 cf = *(const LAS bf16x8*)(lds + ML_CT + (16 * vt + fr) * ML_KROW + (32 * ks + 8 * g) * 2); N2[vt] = MFMA16(cf, qf[ks], N2[vt]); if (vt == 3 && (ks & 1)) __builtin_amdgcn_sched_barrier(0); } }
        __builtin_amdgcn_sched_barrier(0);
        if (k + 1 < nc) ML_PREFETCH_Q(k + 1);
        {
            const float den = rsum + inter * qn, mt = Bc[k * 128 + tq] + Mt;
            const float rden = __builtin_amdgcn_rcpf(fmaxf(fabsf(den), __builtin_amdgcn_exp2f(-mt)));
#pragma unroll
            for (int vt = 0; vt < 4; ++vt) { const f32x4 o = (N1[vt] + N2[vt] * inter) * rden;
                u32x2 w; w.x = pk2(o[0], o[1]); w.y = pk2(o[2], o[3]);
                *(u32x2*)(HO + (size_t)qrow * DM + h * 256 + vs * 64 + 16 * vt + 4 * g) = w; }
        }
#pragma unroll
        for (int dt = 0; dt < 2; ++dt) { nacc[dt] = nacc[dt] * decay;
#pragma unroll
            for (int vt = 0; vt < 4; ++vt) Cacc[dt][vt] = Cacc[dt][vt] * decay; }
#pragma unroll
        for (int ks = 0; ks < 4; ++ks) {
            bf16x8 kf[2], wv[4];
#pragma unroll
            for (int dt = 0; dt < 2; ++dt) { LAS unsigned char* kp2 = lds + ML_K + (32 * ks + 8 * g + (fr >> 2)) * ML_KROW + (32 * wave + 16 * dt + 4 * (fr & 3)) * 2;
                kf[dt] = cat8(tr_read(kp2), tr_read(kp2 + 4 * ML_KROW)); }
#pragma unroll
            for (int vt = 0; vt < 4; ++vt) { LAS unsigned char* vp = lds + ML_VW + (32 * ks + 8 * g + (fr >> 2)) * ML_VROW + (16 * vt + 4 * (fr & 3)) * 2; wv[vt] = cat8(tr_read(vp), tr_read(vp + 4 * ML_VROW)); }
            bf16x8 wc;
            { const f32x4 w0 = *(const LAS f32x4*)(Wv + 32 * ks + 8 * g), w1 = *(const LAS f32x4*)(Wv + 32 * ks + 8 * g + 4);
              const f32x4 z0 = (fr == 0) ? w0 : (f32x4){0.f, 0.f, 0.f, 0.f}, z1 = (fr == 0) ? w1 : (f32x4){0.f, 0.f, 0.f, 0.f}; wc = pack8(z0, z1); }
#pragma unroll
            for (int dt = 0; dt < 2; ++dt) {
#pragma unroll
                for (int vt = 0; vt < 4; ++vt) Cacc[dt][vt] = MFMA16(kf[dt], wv[vt], Cacc[dt][vt]);
                nacc[dt] = MFMA16(kf[dt], wc, nacc[dt]);
            }
            __builtin_amdgcn_sched_barrier(0);
        }
        m_prev = m_new;
    }
#undef ML_OROW
#undef ML_PREFETCH_KV
#undef ML_PREFETCH_Q
    if (!lat) {
        char* oc = (char*)(AOUT + O_NEWC + sidx * 65536 + (size_t)(32 * wave) * 256 + vs * 64);
        unsigned ooff = (unsigned)((4 * g * 256 + fr) * 4); asm volatile("" : "+v"(ooff));
#pragma unroll
        for (int dt = 0; dt < 2; ++dt) {
#pragma unroll
            for (int vt = 0; vt < 4; ++vt)
#pragma unroll
                for (int e = 0; e < 4; ++e) __builtin_nontemporal_store(Cacc[dt][vt][e], (float*)(oc + ooff + (unsigned)(((16 * dt + e) * 256 + 16 * vt) * 4)));
            if (vs == 0 && fr == 0) *(f32x4*)(AOUT + O_NEWN + sidx * 256 + 32 * wave + 16 * dt + 4 * g) = nacc[dt];
        }
        if (vs == 0 && tid == 0) AOUT[O_NEWM + sidx] = m_prev * 0.6931471805599453f;
    }
}

constexpr int N_PHASES = 11;
#ifndef MK_N_LAUNCHES
#define MK_N_LAUNCHES 1
#endif
__global__ void __launch_bounds__(NWAVES * 64, 2) fwd_kernel(Args args_unused) {
    extern __shared__ __attribute__((aligned(16))) unsigned char lds_raw[];
    LAS unsigned char* lds = (LAS unsigned char*)lds_raw;
    volatile LAS unsigned* MISC = (volatile LAS unsigned*)(lds + MISC_OFF);
    const KP kp0 = (KP)__builtin_amdgcn_kernarg_segment_ptr();
    const int lo = *(const int __attribute__((address_space(4)))*)(kp0 + 264), hi = *(const int __attribute__((address_space(4)))*)(kp0 + 268);
    if (threadIdx.x < 64) MISC[threadIdx.x] = 0u;
    __syncthreads();
    const int wave_id = __builtin_amdgcn_readfirstlane((int)threadIdx.x >> 6);
    XcdBarrier bar; bar.bar = nullptr; bar.x = 0; bar.st = nullptr;
    if (hi - lo > 1) { KP kp = kp0; bar = xcd_barrier_post((unsigned*)(AWS + WS_CTL) + CW_BAR, MISC + 8); }
#ifndef PH_MASK
#define PH_MASK 0x7bf
#endif
#define IN(k) (((PH_MASK >> (k)) & 1) && lo <= (k) && (k) < hi)
#ifndef REPEAT_MASK
#define REPEAT_MASK 0
#endif
#ifndef FILL_REP4
#define FILL_REP4 1
#endif
#ifndef FILL_REP
#define FILL_REP 1
#endif
#define NREP(k) (((REPEAT_MASK >> (k)) & 1) ? 2 : 1)
#define SEAM2(k, kn) do { if (IN(k) && IN(kn)) xcd_barrier(bar, TIDX()); } while (0)
#define SEAM(k) SEAM2(k, (k) + 1)
#define TIDX() (wave_id * 64 + (int)__builtin_amdgcn_mbcnt_hi(~0u, __builtin_amdgcn_mbcnt_lo(~0u, 0u)))
#define PHASE_VARS KP kp = kp0; asm volatile("" : "+s"(kp)); int tid = TIDX(); asm volatile("" : "+v"(tid)); const int lane = tid & 63, wave = __builtin_amdgcn_readfirstlane(tid >> 6); \
    const int G = gridDim.x, bx = blockIdx.x, vcu = (G % 8 == 0) ? (bx % 8) * (G / 8) + bx / 8 : bx; unsigned char* ws = AWS; (void)lane; (void)wave; (void)vcu; (void)ws; (void)bx;
    if (IN(0)) for (int rep = 0; rep < NREP(0); ++rep) { PHASE_VARS; p0_prologue(kp, lds, tid, wave, lane, vcu, G); if (rep + 1 < NREP(0)) xcd_barrier(bar, TIDX()); }
    SEAM(0);
    if (IN(1)) for (int rep = 0; rep < NREP(1); ++rep) { PHASE_VARS; p1_pass(kp, tid, wave, lane, vcu, G); }
    SEAM(1);
    if (IN(2)) { PHASE_VARS; pg8::Gemm g{(const bf16_t*)(ws + WS_HH), (const bf16_t*)(ws + WS_W13A), DM, DM, DM, 0, 0}; pg8::Order S; S.init(24, 22, 1, G, bx);
        pg8::EpiSwiGLU E{(bf16_t*)(ws + WS_R + R_U), (const float*)(ws + WS_CTL) + CW_ROWSS, (const float*)(ws + WS_MISC + MISC_SW) + SW_A}; pg8::gemm_phase<pg8::EpiSwiGLU, true>(lds, g, S, E, tid);
        if (bx >= 16 && G > 16) for (int frep = 0; frep < FILL_REP; ++frep) { p0_transposes(kp, lds, wave, lane, (bx - 16) * NWAVES + wave, (G - 16) * NWAVES, 1); p0_misc(kp, (bx - 16) * 512 + tid, (G - 16) * 512); } }
    SEAM(2);
    if (IN(3)) { PHASE_VARS; pg8::Gemm g{(const bf16_t*)(ws + WS_R + R_U), (const bf16_t*)(ws + WS_W2A), FF, FF, FF / 2, FF / 2, FF / 2}; pg8::Order S; S.init(32, 4, 2, G, bx);
        pg8::EpiCombine<0> E{(float*)(ws + WS_R + R_SLAB), (unsigned*)(ws + WS_CTL) + CW_FLG, AIN(I_XP), AIN(I_XS), AOUT + O_Y, (bf16_t*)(ws + WS_HH),
            (float*)(ws + WS_CTL) + CW_ROWSS + MROWS, (LAS float*)(lds + pg8::STAGE_BYTES), (const float*)(ws + WS_MISC + MISC_MODS), (const float*)(ws + WS_MISC + MISC_GS)};
        pg8::gemm_phase<pg8::EpiCombine<0>, true, 3>(lds, g, S, E, tid); }
    SEAM(3);
    if (IN(4)) for (int rep = 0; rep < NREP(4); ++rep) { PHASE_VARS; pg8::Gemm g{(const bf16_t*)(ws + WS_HH), (const bf16_t*)(ws + WS_WIN), DM, DM, DM, 0, 0}; pg8::OrderMixed S; S.o.init(24, 37, 1, G, bx);
        pg8::EpiProj E{ws + WS_R, AOUT + O_NEWK, AOUT + O_NEWV, AIN(I_GQN), AIN(I_GKN), (LAS float*)(lds + pg8::STAGE_BYTES), (const float*)(ws + WS_MISC + MISC_ROPE), (const float*)(ws + WS_CTL) + CW_ROWSS + MROWS,
            (const float*)(ws + WS_MISC + MISC_SW) + SW_C, AIN(I_BGATE), (float*)(ws + WS_G)};
        pg8::gemm_phase<pg8::EpiProj, true, 4, pg8::OrderMixed>(lds, g, S, E, tid);
        if (bx >= 120 && G > 120 && rep == 0) for (int frep = 0; frep < FILL_REP4; ++frep) p0_transposes(kp, lds, wave, lane, (bx - 120) * NWAVES + wave, (G - 120) * NWAVES, 2, frep == 0); if (NREP(4) > 1) __syncthreads(); }
    SEAM(4);
    if (IN(5)) for (int rep = 0; rep < NREP(5); ++rep) {
        PHASE_VARS; unsigned* ctl = (unsigned*)(ws + WS_CTL);
        const float lam = *(const float*)(ws + WS_MISC + MISC_LAM);
        for (;;) {
            __syncthreads();
            if (tid == 0) MISC[16] = xb_add(ctl + CW_QUEUE + 64 * rep, 1u);
            __syncthreads();
            int u = __builtin_amdgcn_readfirstlane((int)MISC[16]);
#if defined(REP_CLASS)
            { constexpr int c0 = REP_CLASS == 0 ? 0 : REP_CLASS == 1 ? 64 : REP_CLASS == 2 ? 192 : 704, cn = REP_CLASS == 0 ? 64 : REP_CLASS == 1 ? 128 : REP_CLASS == 2 ? 512 : 256;
              if (u >= 960 + cn) break;
              if (u >= 960) u = c0 + (u - 960); }
#else
            if (u >= 960) break;
#endif
            int is_attn, latf, i;
            if (u < 64) { is_attn = 0; latf = 1; i = u; } else if (u < 192) { is_attn = 1; latf = 1; i = u - 64; } else if (u < 704) { is_attn = 0; latf = 0; i = u - 192; } else { is_attn = 1; latf = 0; i = u - 704; }
            KP kpu = kp0; asm volatile("" : "+s"(kpu)); int tidu = TIDX(); asm volatile("" : "+v"(tidu));
            const int laneu = tidu & 63, waveu = __builtin_amdgcn_readfirstlane(tidu >> 6);
            if (is_attn) {
                if (latf) attn_unit(kpu, lds, 1, i >> 6, (i >> 3) & 7, i & 7, lam, tidu, waveu, laneu); else attn_unit(kpu, lds, 0, i >> 4, (i >> 1) & 7, i & 1, lam, tidu, waveu, laneu);
            } else {
                mlstm_unit(kpu, lds, latf, i >> 5, (i >> 3) & 3, (i >> 2) & 1, i & 3, tidu, waveu, laneu);
            }
        }
    }
    SEAM2(5, 7);
    if (IN(7)) for (int rep = 0; rep < NREP(7); ++rep) { PHASE_VARS; pg8::Gemm g{(const bf16_t*)(ws + WS_AB), (const bf16_t*)(ws + WS_WBR), 2048, DM, DM, 1024, (size_t)DM * DM}; pg8::Order S; S.init(32, 4, 2, G, bx);
        pg8::Unit u0; const bool has0 = S.next(0, u0);
        if (rep == 0 && has0) hm_rows(kp, u0.pm, u0.pn, u0.z, tid, wave, lane);
        pg8::EpiBranch E{(bf16_t*)(ws + WS_R + R_P), ws + WS_R}; pg8::gemm_phase<pg8::EpiBranch, false, 3>(lds, g, S, E, tid);
        asm volatile("s_waitcnt vmcnt(0)" ::: "memory"); __syncthreads();
        if (rep == 0 && has0 && tid == 0) __hip_atomic_store((unsigned*)(ws + WS_CTL) + CW_DFT + 1024 + (u0.pm * 2 + u0.z) * 4 + u0.pn, 1u, __ATOMIC_RELAXED, __HIP_MEMORY_SCOPE_AGENT); }
    if (IN(8)) { PHASE_VARS; pg8::Gemm g{(const bf16_t*)(ws + WS_R + R_P), (const bf16_t*)(ws + WS_WOUT), 2048, DM, DM, 1024, 0}; pg8::Order S; S.init(32, 4, 2, G, bx);
        { pg8::Unit u0; if (IN(7) && S.next(0, u0)) {
            if (tid < 64) { unsigned* f = (unsigned*)(ws + WS_CTL) + CW_DFT + 1024 + (u0.pm * 2 + u0.z) * 4; unsigned sp = 0u;
                for (;;) { const unsigned v = __hip_atomic_load(f + (lane & 3), __ATOMIC_RELAXED, __HIP_MEMORY_SCOPE_AGENT);
                    if (__builtin_amdgcn_ballot_w64(v == 0u) == 0ull || ++sp > (1u << 22)) break;
                    __builtin_amdgcn_s_sleep(2); }
                __builtin_amdgcn_fence(__ATOMIC_ACQUIRE, "agent"); }
            asm volatile("s_waitcnt vmcnt(0) lgkmcnt(0)" ::: "memory"); __syncthreads(); } }
        pg8::EpiCombine<1> E{(float*)(ws + WS_WIN),
 (unsigned*)(ws + WS_CTL) + CW_FLG + 512, AIN(I_XP), AIN(I_XS), AOUT + O_Y, (bf16_t*)(ws + WS_HH),
            (float*)(ws + WS_CTL) + CW_ROWSS + 2 * MROWS, (LAS float*)(lds + pg8::STAGE_BYTES), (const float*)(ws + WS_MISC + MISC_MODS), (const float*)(ws + WS_MISC + MISC_GS)};
        pg8::gemm_phase<pg8::EpiCombine<1>, true, 3>(lds, g, S, E, tid); }
    SEAM(8);
    if (IN(9)) for (int rep = 0; rep < NREP(9); ++rep) { PHASE_VARS; pg8::Gemm g{(const bf16_t*)(ws + WS_HH), (const bf16_t*)(ws + WS_W13B), DM, DM, DM, 0, 0}; pg8::Order S; S.init(32, 22, 1, G, bx);
        pg8::EpiSwiGLU E{(bf16_t*)(ws + WS_R + R_U), (const float*)(ws + WS_CTL) + CW_ROWSS + 2 * MROWS, (const float*)(ws + WS_MISC + MISC_SW) + SW_F}; pg8::gemm_phase<pg8::EpiSwiGLU, true, 3>(lds, g, S, E, tid); }
    SEAM(9);
    if (IN(10)) { PHASE_VARS; pg8::Gemm g{(const bf16_t*)(ws + WS_R + R_U), (const bf16_t*)(ws + WS_W2B), FF, FF, FF / 2, FF / 2, FF / 2}; pg8::Order S; S.init(32, 4, 2, G, bx);
        pg8::EpiCombine<2> E{(float*)(ws + WS_R + R_SLAB), (unsigned*)(ws + WS_CTL) + CW_FLG + 1024, AIN(I_XP), AIN(I_XS), AOUT + O_Y, (bf16_t*)(ws + WS_HH),
            (float*)(ws + WS_CTL) + CW_ROWSS, (LAS float*)(lds + pg8::STAGE_BYTES), (const float*)(ws + WS_MISC + MISC_MODS), (const float*)(ws + WS_MISC + MISC_GS)};
        pg8::gemm_phase<pg8::EpiCombine<2>, true, 3>(lds, g, S, E, tid); }
#undef IN
#undef SEAM
#undef SEAM2
}

extern "C" void kernel_launch(void* const* d_in, const int* in_sizes, int n_in, void* d_out, int out_size, void* d_ws, size_t ws_size, hipStream_t stream) {
    static int grid = 0;
    if (grid == 0) {
        if (n_in != 31 || (size_t)out_size != O_END || ws_size < WS_END) { fprintf(stderr, "kernel_launch: unexpected shapes (n_in %d, out %d, ws %zu)\n", n_in, out_size, ws_size); grid = -1; return; }
        int dev = 0, cus = 0;
        if (hipGetDevice(&dev) != hipSuccess || hipDeviceGetAttribute(&cus, hipDeviceAttributeMultiprocessorCount, dev) != hipSuccess) { grid = -1; return; }
        if (hipFuncSetAttribute((const void*)fwd_kernel, hipFuncAttributeMaxDynamicSharedMemorySize, LDS_BYTES) != hipSuccess) { grid = -1; return; }
        grid = cus;
    }
    if (grid < 0) return;
    (void)hipMemsetAsync((char*)d_ws + WS_CTL, 0, CTL_ZERO_BYTES, stream);
    Args a{};
    for (int i = 0; i < 31; ++i) a.in[i] = (const float*)d_in[i];
    a.out = (float*)d_out; a.ws = (unsigned char*)d_ws;
#if MK_N_LAUNCHES == 1
    a.ph_lo = 0; a.ph_hi = N_PHASES;
    hipLaunchKernelGGL(fwd_kernel, dim3(grid), dim3(NWAVES * 64), LDS_BYTES, stream, a);
#else
    for (int p = 0; p < N_PHASES; ++p) { a.ph_lo = p; a.ph_hi = p + 1; hipLaunchKernelGGL(fwd_kernel, dim3(grid), dim3(NWAVES * 64), LDS_BYTES, stream, a); }
#endif
}
```

```cpp
#include <hip/hip_runtime.h>
#include <cstdio>
#include <cstdint>

#define LAS __attribute__((address_space(3)))
#define GAS __attribute__((address_space(1)))
typedef unsigned short bf16_t;
typedef short bf16x8 __attribute__((ext_vector_type(8)));
typedef short s16x4 __attribute__((ext_vector_type(4)));
typedef float f32x4 __attribute__((ext_vector_type(4)));
typedef float f32x2 __attribute__((ext_vector_type(2)));
typedef unsigned u32x4 __attribute__((ext_vector_type(4)));
typedef unsigned u32x2 __attribute__((ext_vector_type(2)));

constexpr int DM = 1024, FF = 2816, NCTX = 4096, NLAT = 2048, MROWS = NCTX + NLAT;
constexpr int DIN = 9232, NPROJ = 9216, NMOD = 9;
constexpr float EPS = 1e-6f;

constexpr size_t MiB = 1u << 20;
constexpr size_t WS_CTL = 0, CTL_ZERO_BYTES = 336 * 1024;
constexpr size_t WS_W13A = 2 * MiB, WS_W2A = 13 * MiB, WS_W13B = 19 * MiB, WS_W2B = 30 * MiB, WS_WIN = 36 * MiB, WS_WBR = 55 * MiB, WS_WOUT = 59 * MiB;
constexpr size_t WS_MISC = 61 * MiB;
constexpr size_t MISC_MODS = 0, MISC_ROPE = 192 * 1024, MISC_GS = 208 * 1024, MISC_SW = 256 * 1024, MISC_LAM = 250 * 1024;
constexpr int NWIN = 37 * 256;
constexpr int SW_A = 0, SW_C = 3 * 5632, SW_F = SW_C + 3 * NWIN, SW_END = SW_F + 3 * 5632;
constexpr size_t WS_CK = 62 * MiB, WS_CV = 64 * MiB, WS_G = 66 * MiB, WS_HH = 67 * MiB, WS_HFB = 79 * MiB, WS_AB = 103 * MiB, WS_R = 127 * MiB, WS_END = 235 * MiB;
constexpr size_t PJ = 12 * MiB;
constexpr size_t R_MQ = 0 * PJ, R_MK = 1 * PJ, R_MV = 2 * PJ, R_MOS = 3 * PJ, R_DQ = 4 * PJ, R_DK = 5 * PJ, R_DV = 6 * PJ, R_GM = 7 * PJ, R_GD = 8 * PJ;
constexpr size_t R_U = 0, R_SLAB = 36 * MiB, R_P = 0;
static_assert(MISC_SW + (size_t)SW_END * 4 <= MiB, "MISC map");
constexpr size_t O_Y = 0, O_NEWK = 6291456, O_NEWV = 10485760, O_NEWC = 14680064, O_NEWN = 23068672, O_NEWM = 23101440, O_END = 23101568;
constexpr int CW_QUEUE = 64, CW_DBG = 128, CW_BAR = 4096, CW_CNT = 8192  , CW_FLG = 8192 + 512  , CW_DFT = 12288  , CW_CA = 16384  , CW_CB = 24576  , CW_CC = 28672  , CW_ROWSS = 65536  ;

__device__ __forceinline__ unsigned f2bf(float f) { unsigned u = __builtin_bit_cast(unsigned, f); return (u + 0x7fffu + ((u >> 16) & 1u)) >> 16; }
__device__ __forceinline__ unsigned pk2(float lo, float hi) { unsigned r; asm("v_cvt_pk_bf16_f32 %0, %1, %2" : "=v"(r) : "v"(lo), "v"(hi)); return r; }
__device__ __forceinline__ float bf2f(unsigned h) { return __builtin_bit_cast(float, h << 16); }
__device__ __forceinline__ float bflo(unsigned w) { return __builtin_bit_cast(float, w << 16); }
__device__ __forceinline__ float bfhi(unsigned w) { return __builtin_bit_cast(float, w & 0xffff0000u); }
__device__ __forceinline__ float wave_sum(float v) {
#pragma unroll
    for (int o = 1; o < 64; o <<= 1) v += __shfl_xor(v, o);
    return v;
}
__device__ __forceinline__ float sigmoidf_(float x) { return __builtin_amdgcn_rcpf(1.0f + __expf(-x)); }
__device__ __forceinline__ float siluf_(float x) { return x * __builtin_amdgcn_rcpf(1.0f + __expf(-x)); }
__device__ __forceinline__ float logsigmoidf_(float x) { return fminf(x, 0.f) - __logf(1.0f + __expf(-fabsf(x))); }

#define XB_TMO      128
#define XB_XCNT(j)  (256  + 64 * (j))
#define XB_XSUB(j)  (1280 + 64 * (j))
#define XB_XGEN(j)  (2304 + 64 * (j))
#define XB_TOP      3328
#define XB_TOPGEN   3392
#define XCD_BAR_WORDS 3456
#define XB_SPIN_CAP (1u << 18)
__device__ __forceinline__ unsigned xb_ld(unsigned* p)              { return __hip_atomic_load(p, __ATOMIC_RELAXED, __HIP_MEMORY_SCOPE_AGENT); }
__device__ __forceinline__ unsigned xb_add(unsigned* p, unsigned v) { return __hip_atomic_fetch_add(p, v, __ATOMIC_RELAXED, __HIP_MEMORY_SCOPE_AGENT); }
__device__ __forceinline__ unsigned xb_xcc_id() { return (unsigned)__builtin_amdgcn_s_getreg((3 << 11) | 20) & 0xFu; }
#define XB_SPIN(cond, bar) do { unsigned _sp = 0; while (cond) { __builtin_amdgcn_s_sleep(1); \
    if ((++_sp & 255u) == 0u) { if (xb_ld(&(bar)[XB_TMO])) break; if (_sp > XB_SPIN_CAP) { atomicAdd(&(bar)[XB_TMO], 1u); break; } } } } while (0)
struct XcdBarrier { unsigned* bar; unsigned x; volatile LAS unsigned* st; };
__device__ __forceinline__ XcdBarrier xcd_barrier_post(unsigned* bar, volatile LAS unsigned* st) {
    XcdBarrier b; b.bar = bar; b.x = xb_xcc_id(); b.st = st;
    if (threadIdx.x == 0) (void)xb_add(&bar[XB_XCNT(b.x)], 1u);
    return b;
}
__device__ __forceinline__ void xcd_barrier_complete(unsigned* bar, unsigned x, unsigned& nloc, unsigned& nx) {
    const unsigned G = gridDim.x * gridDim.y * gridDim.z;
    unsigned sum, cnt, mine, sp = 0u;
    for (;;) {
        sum = 0u; cnt = 0u; mine = 0u;
#pragma unroll
        for (unsigned j = 0; j < 16; ++j) { const unsigned c = xb_ld(&bar[XB_XCNT(j)]); sum += c; cnt += (c > 0u) ? 1u : 0u; mine = (j == x) ? c : mine; }
        if (sum == G) break;
        __builtin_amdgcn_s_sleep(1);
        if ((++sp & 255u) == 0u) { if (xb_ld(&bar[XB_TMO])) break; if (sp > XB_SPIN_CAP) { atomicAdd(&bar[XB_TMO], 1u); break; } }
    }
    nloc = mine > 0u ? mine : 1u; nx = cnt > 0u ? cnt : 1u;
}
__device__ __forceinline__ void xcd_barrier(const XcdBarrier& b, int tid) {
    asm volatile("s_waitcnt vmcnt(0)" ::: "memory");
    __syncthreads();
    if (tid == 0) {
        unsigned* bar = b.bar;
        __builtin_amdgcn_s_waitcnt(0);
        unsigned nloc = b.st[0], nx = b.st[1];
        if (nloc == 0u) { xcd_barrier_complete(bar, b.x, nloc, nx); b.st[0] = nloc; b.st[1] = nx; }
        const unsigned old = xb_add(&bar[XB_XSUB(b.x)], 1u);
        const unsigned gen = old / nloc;
        if (old + 1u == (gen + 1u) * nloc) {
            __builtin_amdgcn_fence(__ATOMIC_RELEASE, "agent");
            asm volatile("s_waitcnt vmcnt(0)" ::: "memory");
            const unsigned og = xb_add(&bar[XB_TOP], 1u);
            const unsigned tg = og / nx;
            if (og + 1u == (tg + 1u) * nx) xb_add(&bar[XB_TOPGEN], 1u);
            else XB_SPIN(xb_ld(&bar[XB_TOPGEN]) == tg, bar);
            __builtin_amdgcn_fence(__ATOMIC_ACQUIRE, "agent");
            xb_add(&bar[XB_XGEN(b.x)], 1u);
            asm volatile("s_waitcnt vmcnt(0)" ::: "memory");
        } else {
            XB_SPIN(xb_ld(&bar[XB_XGEN(b.x)]) == gen, bar);
            __builtin_amdgcn_fence(__ATOMIC_ACQUIRE, "agent");
            asm volatile("s_waitcnt vmcnt(0)" ::: "memory");
        }
    }
    __syncthreads();
}
namespace pg8 {
constexpr int BM = 256, BK = 64, HALF = 128, HTB = HALF * BK * 2  , STAGE_BYTES = 8 * HTB, NXCD = 8, WGM = 8;
__host__ __device__ __forceinline__ int lds_byte(int r, int c) { const int st = (r >> 4) * 2 + (c >> 5), rr = r & 15, cc = c & 31, ob = rr * 64 + cc * 2; return st * 1024 + (ob ^ (((ob >> 9) & 1) << 5)); }
__host__ __device__ __forceinline__ void stage_rc(int b, int& R, int& C) { const int st = b / 1024, sb = b % 1024, swz = sb ^ (((sb >> 9) & 1) << 5); R = (st >> 1) * 16 + swz / 64; C = (st & 1) * 32 + (swz % 64) / 2; }
__host__ __device__ __forceinline__ int perm32(int rho) { const int n = rho >> 4, i = rho & 15; return 8 * (i >> 2) + 4 * n + (i & 3); }

struct Unit { int pm, pn, z; };
struct Gemm { const bf16_t* A; const bf16_t* Bt; int lda, ldb, K; size_t zA, zB; };

struct Order {
    int nM, nN, nNz, nwg, G, c;
    __device__ __forceinline__ void init(int nM_, int nN_, int nZ_, int G_, int c_) { nM = nM_; nN = nN_; nNz = nN_ * nZ_; nwg = nM * nNz; G = G_; c = c_; }
    __device__ __forceinline__ bool next(int i, Unit& u) const {
        const long L = (long)i * G + c; if (L >= nwg) return false;
        int wgid = (int)L; { const int q = nwg / NXCD, r = nwg % NXCD, xcd = wgid % NXCD, off = wgid / NXCD; wgid = (xcd < r ? xcd * (q + 1) : r * (q + 1) + (xcd - r) * q) + off; }
        const int nig = WGM * nNz, gid = wgid / nig, fm = gid * WGM, gsz = (nM - fm) < WGM ? (nM - fm) : WGM;
        u.pm = fm + ((wgid % nig) % gsz); const int pnz = (wgid % nig) / gsz; u.z = pnz / nN; u.pn = pnz % nN; return true;
    }
};

struct OrderMixed { Order o;
    __device__ __forceinline__ bool next(int i, Unit& u) const {
        if (!o.next(i, u)) return false;
        if (u.pn < 36) u.pn = (int)((0x638251704ull >> (4 * (u.pn >> 2))) & 15ull) * 4 + (u.pn & 3);
        return true; }
};
__device__ __forceinline__ void st16_wt(void* p, u32x4 v) { asm volatile("global_store_dwordx4 %0, %1, off sc1\n\ts_nop 1" :: "v"(p), "v"(v) : "memory"); }
__device__ __forceinline__ void st16_wt(void* p, f32x4 v) { asm volatile("global_store_dwordx4 %0, %1, off sc1\n\ts_nop 1" :: "v"(p), "v"(v) : "memory"); }
__device__ __forceinline__ unsigned cvt_pk_bf16(float lo, float hi) { unsigned r; asm volatile("v_cvt_pk_bf16_f32 %0, %1, %2" : "=v"(r) : "v"(lo), "v"(hi)); return r; }


__device__ __forceinline__ int mods_index(int pm) { return pm < 16 ? 0 : 1 + ((pm - 16) >> 2); }
__device__ __forceinline__ int mods_row(int r) { return r < NCTX ? 0 : 1 + ((r - NCTX) >> 10); }

struct EpiSwiGLU {
    static constexpr bool PERM = true;
    bf16_t* U; const float* rowss; const float* sw;
    __device__ __forceinline__ void pre_issue(int, f32x4 (&)[3]) const {}
    __device__ __forceinline__ void pre_commit(int, const f32x4 (&)[3]) const {}
    template <int MT> __device__ __forceinline__ void operator()(const f32x4 (&acc)[2][2][MT][2], const Unit& u, int wr, int wc, int fr, int fq) const {
        constexpr int BMR = 64 * MT, HM = 32 * MT;
        const int row0 = u.pm * BMR + wr * (16 * MT) + fr, col0 = u.pn * 128 + wc * 32 + 8 * fq;
        const int mi0 = mods_row(u.pm * BMR), mi1 = mods_row(u.pm * BMR + BMR - 1), rb = mi1 == 2 ? NCTX + 1024 : NCTX;
        const float* s = sw + mi0 * 5632 + u.pn * BM + wc * 32 + 8 * fq;
        const f32x4 s10 = *(const f32x4*)s, s11 = *(const f32x4*)(s + 4), s30 = *(const f32x4*)(s + HALF), s31 = *(const f32x4*)(s + HALF + 4);
        f32x4 t10 = s10, t11 = s11, t30 = s30, t31 = s31;
        if (MT != 4) { const float* t = s + (mi1 - mi0) * 5632; t10 = *(const f32x4*)t; t11 = *(const f32x4*)(t + 4); t30 = *(const f32x4*)(t + HALF); t31 = *(const f32x4*)(t + HALF + 4); }
        float rsv[2][MT];
#pragma unroll
        for (int ai = 0; ai < 2; ++ai)
#pragma unroll
            for (int m = 0; m < MT; ++m) rsv[ai][m] = rowss[row0 + ai * HM + m * 16];
#define SWIGLU_ROWS(SEL) _Pragma("unroll") for (int ai = 0; ai < 2; ++ai) _Pragma("unroll") for (int m = 0; m < MT; ++m) { \
                const int r = row0 + ai * HM + m * 16; \
                const float rstd = rsqrtf(rsv[ai][m] * (1.0f / DM) + EPS); \
                bf16_t* rowp = U + (size_t)r * FF + col0; \
                const bool hi_ = (SEL) && r >= rb; \
                const f32x4 a10 = acc[ai][0][m][0] * rstd + (hi_ ? t10 : s10), a11 = acc[ai][0][m][1] * rstd + (hi_ ? t11 : s11), a30 = acc[ai][1][m][0] * rstd + (hi_ ? t30 : s30), a31 = acc[ai][1][m][1] * rstd + (hi_ ? t31 : s31); \
                f32x4 v0, v1; \
                _Pragma("unroll") for (int e = 0; e < 4; ++e) { v0[e] = siluf_(a10[e]) * a30[e]; v1[e] = siluf_(a11[e]) * a31[e]; } \
                u32x4 w; w.x = cvt_pk_bf16(v0[0], v0[1]); w.y = cvt_pk_bf16(v0[2], v0[3]); w.z = cvt_pk_bf16(v1[0], v1[1]); w.w = cvt_pk_bf16(v1[2], v1[3]); \
                *(u32x4*)rowp = w; }
        if (MT != 4 && mi0 != mi1) { SWIGLU_ROWS(true) } else { SWIGLU_ROWS(false) }
#undef SWIGLU_ROWS
    }
};
struct EpiProj {
    static constexpr bool PERM = false;
    unsigned char* R; float* newk; float* newv; const float* gq; const float* gk; LAS float* ropel; const float* rope; const float* rowss; const float* sw; const float* bgate; float* G;
    __device__ __forceinline__ void pre_issue(int tid, f32x4 (&r)[3]) const { r[0] = ((const f32x4*)rope)[tid]; }
    __device__ __forceinline__ void pre_commit(int tid, const f32x4 (&r)[3]) const { ((LAS f32x4*)ropel)[tid] = r[0]; }
    template <int MT> __device__ __forceinline__ void operator()(const f32x4 (&acc)[2][2][MT][2], const Unit& u, int wr, int wc, int fr, int fq) const {
        static_assert(MT == 4, "256-row tiles only");
        const int grp = u.pn >> 2, mi = mods_index(u.pm);
        const float* s = sw + mi * NWIN + u.pn * BM + wc * 32 + 4 * fq;
        if (u.pn == 36) {
            if (wc != 0) return;
            const f32x4 sg = *(const f32x4*)s + *(const f32x4*)(s + 16) + *(const f32x4*)(bgate + 4 * fq);
#pragma unroll
            for (int ai = 0; ai < 2; ++ai)
#pragma unroll
                for (int m = 0; m < 4; ++m) { const int r = u.pm * BM + ai * HALF + wr * 64 + m * 16 + fr;
                    const float rstd = rsqrtf(rowss[r] * (1.0f / DM) + EPS);
                    f32x4 x = (acc[ai][0][m][0] + acc[ai][0][m][1]) * rstd + sg;
                    if (fq & 1) {
#pragma unroll
                        for (int e = 0; e < 4; ++e) x[e] = logsigmoidf_(x[e]); }
                    *(f32x4*)(G + (size_t)r * 16 + 4 * fq) = x; }
            return;
        }
        f32x4 sv[2][2];
#pragma unroll
        for (int bj = 0; bj < 2; ++bj)
#pragma unroll
            for (int n = 0; n < 2; ++n) sv[bj][n] = *(const f32x4*)(s + bj * HALF + n * 16);
        bf16_t* dst = (bf16_t*)(R + (size_t)grp * PJ);
        const int cw = (u.pn & 3) * 256 + 64 * wc;
        float rsv[2][4];
#pragma unroll
        for (int ai = 0; ai < 2; ++ai)
#pragma unroll
            for (int m = 0; m < 4; ++m) rsv[ai][m] = rowss[u.pm * BM + ai * HALF + wr * 64 + m * 16 + fr];
        f32x4 gvv[2][2];
        if (grp == 4 || grp == 5) { const float* gw = (grp == 4) ? gq : gk;
#pragma unroll
            for (int bj = 0; bj < 2; ++bj)
#pragma unroll
                for (int n = 0; n < 2; ++n) gvv[bj][n] = *(const f32x4*)(gw + 32 * bj + 16 * n + 4 * fq); }

#pragma unroll
        for (int ai = 0; ai < 2; ++ai)
#pragma unroll
            for (int m = 0; m < 4; ++m) {
                const int r = u.pm * BM + ai * HALF + wr * 64 + m * 16 + fr;
                const float rs = rsqrtf(rsv[ai][m] * (1.0f / DM) + EPS);
                f32x4 v[2][2];
#pragma unroll
                for (int bj = 0; bj < 2; ++bj)
#pragma unroll
                    for (int n = 0; n < 2; ++n) v[bj][n] = acc[ai][bj][m][n] * rs + sv[bj][n];
                if (grp == 4 || grp == 5) {
                    const int cbase = cw + 4 * fq;
                    float ss = 0.f;
#pragma unroll
                    for (int bj = 0; bj < 2; ++bj)
#pragma unroll
                        for (int n = 0; n < 2; ++n) ss += (v[bj][n][0] * v[bj][n][0] + v[bj][n][1] * v[bj][n][1]) + (v[bj][n][2] * v[bj][n][2] + v[bj][n][3] * v[bj][n][3]);
                    ss += __shfl_xor(ss, 16); ss += __shfl_xor(ss, 32);
                    const float rstd = rsqrtf(ss * (1.0f / 64.0f) + EPS);
#pragma unroll
                    for (int bj = 0; bj < 2; ++bj)
#pragma unroll
                        for (int n = 0; n < 2; ++n) v[bj][n] = v[bj][n] * rstd * gvv[bj][n];
                    if (r >= NCTX) {
                        const int t = (r - NCTX) & 1023;
#pragma unroll
                        for (int bj = 0; bj < 2; ++bj) {
                            const int pos = bj ? (t & 63) : (t >> 6);
                            const f32x4 a = *(const LAS f32x4*)(ropel + (pos * 16 + 4 * fq) * 2), b = *(const LAS f32x4*)(ropel + (pos * 16 + 4 * fq) * 2 + 4);
                            const f32x4 cs = {a[0], a[2], b[0], b[2]}, sn = {a[1], a[3], b[1], b[3]};
                            const f32x4 x1 = v[bj][0], x2 = v[bj][1];
                            v[bj][0] = x1 * cs - x2 * sn; v[bj][1] = x2 * cs + x1 * sn;
                        }
                    } else if (grp == 5) {
#pragma unroll
                        for (int bj = 0; bj < 2; ++bj)
#pragma unroll
                            for (int n = 0; n < 2; ++n) __builtin_nontemporal_store(v[bj][n], (f32x4*)(newk + (size_t)r * DM + cbase + 32 * bj + 16 * n));
                    }
                    if (grp == 4) {
#pragma unroll
                        for (int bj = 0; bj < 2; ++bj)
#pragma unroll
                            for (int n = 0; n < 2; ++n) v[bj][n] = v[bj][n] * 0.18033688011112042f;
                    }
#pragma unroll
                    for (int bj = 0; bj < 2; ++bj)
#pragma unroll
                        for (int n = 0; n < 2; ++n) { u32x2 w; w.x = cvt_pk_bf16(v[bj][n][0], v[bj][n][1]); w.y = cvt_pk_bf16(v[bj][n][2], v[bj][n][3]);
                            *(u32x2*)(dst + (size_t)r * DM + cbase + 32 * bj + 16 * n) = w; }
                } else {
                    const int cbase = cw + 8 * fq;
                    if (grp == 0) {
#pragma unroll
                        for (int bj = 0; bj < 2; ++bj)
#pragma unroll
                            for (int n = 0; n < 2; ++n) v[bj][n] = v[bj][n] * 0.0625f;
                    } else if (grp >= 7) {
#pragma unroll
                        for (int bj = 0; bj < 2; ++bj)
#pragma unroll
                            for (int n = 0; n < 2; ++n)
#pragma unroll
                                for (int e = 0; e < 4; ++e) v[bj][n][e] = sigmoidf_(v[bj][n][e]);
                    } else if (grp == 6 && r < NCTX) {
#pragma unroll
                        for (int bj = 0; bj < 2; ++bj)
#pragma unroll
                            for (int n = 0; n < 2; ++n) __builtin_nontemporal_store(v[bj][n], (f32x4*)(newv + (size_t)r * DM + cbase + 32 * bj + 4 * n));
                    }
#pragma unroll
                    for (int bj = 0; bj < 2; ++bj) { u32x4 w; w.x = cvt_pk_bf16(v[bj][0][0], v[bj][0][1]); w.y = cvt_pk_bf16(v[bj][0][2], v[bj][0][3]); w.z = cvt_pk_bf16(v[bj][1][0], v[bj][1][1]); w.w = cvt_pk_bf16(v[bj][1][2], v[bj][1][3]);
                        *(u32x4*)(dst + (size_t)r * DM + cbase + 32 * bj) = w; }
                }
            }
    }
};
struct EpiBranch {
    static constexpr bool PERM = true;
    bf16_t* P; const unsigned char* R;
    __device__ __forceinline__ void pre_issue(int, f32x4 (&)[3]) const {}
    __device__ __forceinline__ void pre_commit(int, const f32x4 (&)[3]) const {}
    template <int MT> __device__ __forceinline__ void operator()(const f32x4 (&acc)[2][2][MT][2], const Unit& u, int wr, int wc, int fr, int fq) const {
        constexpr int BMR = 64 * MT, HM = 32 * MT;
        const bf16_t* sg = (const bf16_t*)(R + (u.z ? R_GD : R_GM));
        const int row0 = u.pm * BMR + wr * (16 * MT) + fr, col0 = u.pn * BM + wc * 32 + 8 * fq;
        u32x4 gg[2][MT][2];
#pragma unroll
        for (int ai = 0; ai < 2; ++ai)
#pragma unroll
            for (int m = 0; m < MT; ++m)
#pragma unroll
                for (int bj = 0; bj < 2; ++bj) gg[ai][m][bj] = *(const u32x4*)(sg + (size_t)(row0 + ai * HM + m * 16) * DM + col0 + bj * HALF);
#pragma unroll
        for (int ai = 0; ai < 2; ++ai) {
#pragma unroll
            for (int m = 0; m < MT; ++m) { const int r = row0 + ai * HM + m * 16;
#pragma unroll
                for (int bj = 0; bj < 2; ++bj) { const int c = col0 + bj * HALF;
                    const u32x4 g = gg[ai][m][bj];
                    const f32x4 a0 = acc[ai][bj][m][0], a1 = acc[ai][bj][m][1];
                    u32x4 w; w.x = cvt_pk_bf16(a0[0] * bflo(g.x), a0[1] * bfhi(g.x)); w.y = cvt_pk_bf16(a0[2] * bflo(g.y), a0[3] * bfhi(g.y));
                    w.z = cvt_pk_bf16(a1[0] * bflo(g.z), a1[1] * bfhi(g.z)); w.w = cvt_pk_bf16(a1[2] * bflo(g.w), a1[3] * bfhi(g.w));
                    st16_wt(P + (size_t)r * 2048 + (size_t)u.z * 1024 + c, w); } } }
    }
};
__device__ __forceinline__ void store_sc1(float* p, f32x4 v) { asm volatile("global_store_dwordx4 %0, %1, off sc1\n\ts_nop 1" :: "v"(p), "v"(v) : "memory"); }
template <int MODE> struct EpiCombine {
    static constexpr bool PERM = false;
    float* slab; unsigned* flg; const float* xp; const float* xs; float* Y; bf16_t* HH; float* rowss; LAS float* gl;
    static constexpr int GIDX = MODE == 0 ? 2 : (MODE == 1 ? 5 : 8); static constexpr float GSC = MODE == 1 ? 1.0f : 0.5f;
    const float* mods; const float* gs;
    __device__ __forceinline__ void pre_issue(int tid, f32x4 (&r)[3]) const {
#pragma unroll
        for (int j = 0; j < 3; ++j) { const int q = tid + 512 * j, q2 = q < 768 ? q : q - 768, mi = q2 >> 8, c = (q2 & 255) * 4;
            if (q < 768) r[j] = *(const f32x4*)(mods + (mi * NMOD + GIDX) * DM + c) * GSC; else if (MODE != 2) r[j] = *(const f32x4*)(gs + ((MODE + 1) * 3 + mi) * DM + c); }
    }
    __device__ __forceinline__ void pre_commit(int tid, const f32x4 (&r)[3]) const {
#pragma unroll
        for (int j = 0; j < 3; ++j) { const int q = tid + 512 * j; if (q < 768 || MODE != 2) ((LAS f32x4*)gl)[q] = r[j]; }
    }
    template <int AI, int MT> __device__ __forceinline__ void half(const f32x4 (&acc)[2][2][MT][2], const Unit& u, int wr, int wc, int fr, int fq) const {
        constexpr int BMR = 64 * MT, HM = 32 * MT;
        const int tile = u.pm * 4 + u.pn, wid = wr * 4 + wc, lane = fq * 16 + fr, tid = wid * 64 + lane;
        unsigned char* mine = (unsigned char*)slab + ((size_t)(tile * 2 + AI) * 8 + wid) * 8192 + lane * 16;
#pragma unroll
        for (int m = 0; m < MT; ++m)
#pragma unroll
            for (int bj = 0; bj < 2; ++bj) { const f32x4 a0 = acc[1 - AI][bj][m][0], a1 = acc[1 - AI][bj][m][1];
                u32x4 w; w.x = cvt_pk_bf16(a0[0], a0[1]); w.y = cvt_pk_bf16(a0[2], a0[3]); w.z = cvt_pk_bf16(a1[0], a1[1]); w.w = cvt_pk_bf16(a1[2], a1[3]);
                st16_wt(mine + (m * 2 + bj) * 1024, w); }
        asm volatile("s_waitcnt vmcnt(0)" ::: "memory"); __builtin_amdgcn_s_barrier(); asm volatile("" ::: "memory");
        if (tid == 0) __hip_atomic_store(flg + tile * 2 + AI, 1u, __ATOMIC_RELAXED, __HIP_MEMORY_SCOPE_AGENT);
        asm volatile("" ::: "memory");
        const int col0 = u.pn * BM + wc * 32 + 4 * fq;
        const int rbase = u.pm * BMR + AI * HM + wr * (16 * MT) + fr;
        if constexpr (MT == 4) {
        if (tid == 0) { unsigned sp = 0u;
            while (__hip_atomic_load(flg + tile * 2 + (1 - AI), __ATOMIC_RELAXED, __HIP_MEMORY_SCOPE_AGENT) == 0u) { __builtin_amdgcn_s_sleep(2); if (++sp > (1u << 22)) break; }
            __builtin_amdgcn_fence(__ATOMIC_ACQUIRE, "agent"); }
        asm volatile("s_waitcnt vmcnt(0) lgkmcnt(0)" ::: "memory"); __builtin_amdgcn_s_barrier(); asm volatile("" ::: "memory");
        const unsigned char* theirs = (const unsigned char*)slab + ((size_t)(tile * 2 + (1 - AI)) * 8 + wid) * 8192 + lane * 16;
#pragma unroll
        for (int m = 0; m < MT; ++m) { const int r = rbase + m * 16; const size_t off = (size_t)r * DM + col0;
            const float* xres = MODE == 0 ? (r < NCTX ? xp + off : xs + (off - (size_t)NCTX * DM)) : Y + off;
            const LAS float* gp = gl + mods_row(r) * DM + col0;
            f32x4 T[2][2], X[2][2];
            u32x4 tw[2];
#pragma unroll
            for (int bj = 0; bj < 2; ++bj) { tw[bj] = *(const u32x4*)(theirs + (m * 2 + bj) * 1024);
#pragma unroll
                for (int n = 0; n < 2; ++n) X[bj][n] = (MODE == 0) ? __builtin_nontemporal_load((const f32x4*)(xres + bj * HALF + n * 16)) : *(const f32x4*)(xres + bj * HALF + n * 16); }
#pragma unroll
            for (int bj = 0; bj < 2; ++bj) { T[bj][0] = (f32x4){bflo(tw[bj].x), bfhi(tw[bj].x), bflo(tw[bj].y), bfhi(tw[bj].y)}; T[bj][1] = (f32x4){bflo(tw[bj].z), bfhi(tw[bj].z), bflo(tw[bj].w), bfhi(tw[bj].w)}; }
            float ss = 0.f;
#pragma unroll
            for (int bj = 0; bj < 2; ++bj)
#pragma unroll
                for (int n = 0; n < 2; ++n) { const int o = bj * HALF + n * 16;
                    const f32x4 v = acc[AI][bj][m][n] + T[bj][n];
                    const f32x4 xn = X[bj][n] + *(const LAS f32x4*)(gp + o) * v;
                    if (MODE == 2) __builtin_nontemporal_store(xn, (f32x4*)(Y + off + o)); else *(f32x4*)(Y + off + o) = xn;
                    if (MODE != 2) { ss += (xn[0] * xn[0] + xn[1] * xn[1]) + (xn[2] * xn[2] + xn[3] * xn[3]);
                        const f32x4 h = xn * *(const LAS f32x4*)(gp + 3 * DM + o); u32x2 w; w.x = cvt_pk_bf16(h[0], h[1]); w.y = cvt_pk_bf16(h[2], h[3]);
                        *(u32x2*)(HH + off + o) = w; } }
            if (MODE != 2) { ss += __shfl_xor(ss, 16); ss += __shfl_xor(ss, 32); if (fq == 0) atomicAdd(rowss + r, ss); }
        }
        } else {
        f32x4 X[MT][2][2];
#pragma unroll
        for (int m = 0; m < MT; ++m) { const int r = rbase + m * 16; const size_t off = (size_t)r * DM + col0;
            const float* xres = MODE == 0 ? (r < NCTX ? xp + off : xs + (off - (size_t)NCTX * DM)) : Y + off;
#pragma unroll
            for (int bj = 0; bj < 2; ++bj)
#pragma unroll
                for (int n = 0; n < 2; ++n) X[m][bj][n] = (MODE == 0) ? __builtin_nontemporal_load((const f32x4*)(xres + bj * HALF + n * 16)) : *(const f32x4*)(xres + bj * HALF + n * 16); }
        asm volatile("" ::: "memory");
        if (tid == 0) { unsigned sp = 0u;
            while (__hip_atomic_load(flg + tile * 2 + (1 - AI), __ATOMIC_RELAXED, __HIP_MEMORY_SCOPE_AGENT) == 0u) { __builtin_amdgcn_s_sleep(2); if (++sp > (1u << 22)) break; }
            __builtin_amdgcn_fence(__ATOMIC_ACQUIRE, "agent"); }
        asm volatile("s_waitcnt vmcnt(0) lgkmcnt(0)" ::: "memory"); __builtin_amdgcn_s_barrier(); asm volatile("" ::: "memory");
        const unsigned char* theirs = (const unsigned char*)slab + ((size_t)(tile * 2 + (1 - AI)) * 8 + wid) * 8192 + lane * 16;
        u32x4 tw[MT][2];
#pragma unroll
        for (int m = 0; m < MT; ++m)
#pragma unroll
            for (int bj = 0; bj < 2; ++bj) tw[m][bj] = *(const u32x4*)(theirs + (m * 2 + bj) * 1024);
#pragma unroll
        for (int m = 0; m < MT; ++m) { const int r = rbase + m * 16; const size_t off = (size_t)r * DM + col0;
            const LAS float* gp = gl + mods_row(r) * DM + col0;
            f32x4 T[2][2];
#pragma unroll
            for (int bj = 0; bj < 2; ++bj) { T[bj][0] = (f32x4){bflo(tw[m][bj].x), bfhi(tw[m][bj].x), bflo(tw[m][bj].y), bfhi(tw[m][bj].y)}; T[bj][1] = (f32x4){bflo(tw[m][bj].z), bfhi(tw[m][bj].z), bflo(tw[m][bj].w), bfhi(tw[m][bj].w)}; }
            float ss = 0.f;
#pragma unroll
            for (int bj = 0; bj < 2; ++bj)
#pragma unroll
                for (int n = 0; n < 2; ++n) { const int o = bj * HALF + n * 16;
                    const f32x4 v = acc[AI][bj][m][n] + T[bj][n];
                    const f32x4 xn = X[m][bj][n] + *(const LAS f32x4*)(gp + o) * v;
                    if (MODE == 2) __builtin_nontemporal_store(xn, (f32x4*)(Y + off + o)); else *(f32x4*)(Y + off + o) = xn;
                    if (MODE != 2) { ss += (xn[0] * xn[0] + xn[1] * xn[1]) + (xn[2] * xn[2] + xn[3] * xn[3]);
                        const f32x4 h = xn * *(const LAS f32x4*)(gp + 3 * DM + o); u32x2 w; w.x = cvt_pk_bf16(h[0], h[1]); w.y = cvt_pk_bf16(h[2], h[3]);
                        *(u32x2*)(HH + off + o) = w; } }
            if (MODE != 2) { ss += __shfl_xor(ss, 16); ss += __shfl_xor(ss, 32); if (fq == 0) atomicAdd(rowss + r, ss); }
        }
        }
    }
    template <int MT> __device__ __forceinline__ void operator()(const f32x4 (&acc)[2][2][MT][2], const Unit& u, int wr, int wc, int fr, int fq) const {
        if (u.z == 0) half<0, MT>(acc, u, wr, wc, fr, fq); else half<1, MT>(acc, u, wr, wc, fr, fq);
    }
};

template <class Epi, bool ALIGN_EPI, int MT = 4, class Sched = Order>
__device__ __forceinline__ void gemm_phase(LAS unsigned char* lds, const Gemm g, const Sched& S, const Epi& E, int tid_in) {
    int tid = tid_in; asm volatile("" : "+v"(tid));
    const int wid = __builtin_amdgcn_readfirstlane(tid >> 6), lane = tid & 63, wr = wid >> 2, wc = wid & 3, fr = lane & 15, fq = lane >> 4;
    const int K = g.K, nt = K / BK;
    unsigned voffA[2], voffB[2];
#pragma unroll
    for (int i = 0; i < 2; ++i) { int R, C; stage_rc(tid * 16 + i * 8192, R, C); const int Rb = Epi::PERM ? ((R & ~31) + perm32(R & 31)) : R;
        const int Ra = R < 32 * MT ? R : R - 32 * MT;
        voffA[i] = (unsigned)(Ra * g.lda + C) * 2u; voffB[i] = (unsigned)(Rb * g.ldb + C) * 2u; }
    const size_t kstep = (size_t)(BK * 2);
    const size_t hstepA = (size_t)(32 * MT) * g.lda * 2, hstepB = (size_t)HALF * g.ldb * 2;
    const unsigned ldsw = (unsigned)wid * 1024u;
    const int aoff = lds_byte(wr * (16 * MT) + fr, fq * 8), boff = lds_byte(wc * 32 + fr, fq * 8);
#define PG8_SA(b, h) (((b) * 2 + (h)) * HTB)
#define PG8_SB(b, h) ((4 + (b) * 2 + (h)) * HTB)
#define PG8_STAGE(bufoff, gbase, voff) do { _Pragma("unroll") for (int _i = 0; _i < 2; ++_i) \
        __builtin_amdgcn_global_load_lds((const unsigned*)((const char*)(gbase) + (voff)[_i]), (LAS unsigned*)(lds + (bufoff) + ldsw + _i * 8192), 16, 0, 0); } while (0)
#define PG8_LDA(dst, b, h) do { _Pragma("unroll") for (int m = 0; m < MT; ++m) _Pragma("unroll") for (int k = 0; k < 2; ++k) dst[m][k] = *(const LAS bf16x8*)(lds + PG8_SA(b, h) + aoff + m * 2048 + k * 1024); } while (0)
#define PG8_LDB(dst, b, h) do { _Pragma("unroll") for (int n = 0; n < 2; ++n) _Pragma("unroll") for (int k = 0; k < 2; ++k) dst[n][k] = *(const LAS bf16x8*)(lds + PG8_SB(b, h) + boff + n * 2048 + k * 1024); } while (0)
#define PG8_MMA(ai, bj, At, Bt) do { __builtin_amdgcn_s_setprio(1); _Pragma("unroll") for (int m = 0; m < MT; ++m) _Pragma("unroll") for (int n = 0; n < 2; ++n) _Pragma("unroll") for (int k = 0; k < 2; ++k) \
        acc[ai][bj][m][n] = __builtin_amdgcn_mfma_f32_16x16x32_bf16(Bt[n][k], At[m][k], acc[ai][bj][m][n], 0, 0, 0); __builtin_amdgcn_s_setprio(0); } while (0)
#define PG8_WAIT_V(n) asm volatile("s_waitcnt vmcnt(" #n ")" ::: "memory")
#define PG8_WAIT_L(n) asm volatile("s_waitcnt lgkmcnt(" #n ")" ::: "memory")
#define PG8_BAR __builtin_amdgcn_s_barrier()
#define PG8_SCHED __builtin_amdgcn_sched_barrier(0)
#define PG8_UA(u) ((const char*)g.A + ((size_t)(u).pm * (64 * MT) * g.lda + (size_t)(u).z * g.zA) * 2)
#define PG8_UB(u) ((const char*)g.Bt + ((size_t)(u).pn * BM * g.ldb + (size_t)(u).z * g.zB) * 2)
    Unit cur, nxt; int ui = 0;
    if (!S.next(0, cur)) return;
    f32x4 acc[2][2][MT][2];
#pragma unroll
    for (int a = 0; a < 2; ++a)
#pragma unroll
        for (int b = 0; b < 2; ++b)
#pragma unroll
            for (int m = 0; m < MT; ++m)
#pragma unroll
                for (int n = 0; n < 2; ++n) acc[a][b][m][n] = (f32x4){0.f, 0.f, 0.f, 0.f};
    bf16x8 At[MT][2], B0[2][2], B1[2][2];
    const char* cA = PG8_UA(cur); const char* cB = PG8_UB(cur);
    f32x4 pre[3]; E.pre_issue(tid, pre);
    PG8_STAGE(PG8_SB(0, 0), cB, voffB); PG8_STAGE(PG8_SB(0, 1), cB + hstepB, voffB); PG8_STAGE(PG8_SA(0, 0), cA, voffA); PG8_STAGE(PG8_SA(0, 1), cA + hstepA, voffA);
    E.pre_commit(tid, pre);
    if (wr == 1) PG8_BAR;
    PG8_WAIT_V(2); PG8_BAR;
    PG8_STAGE(PG8_SB(1, 0), cB + kstep, voffB); PG8_STAGE(PG8_SA(1, 0), cA + kstep, voffA); PG8_STAGE(PG8_SB(1, 1), cB + hstepB + kstep, voffB);
    PG8_WAIT_V(6); PG8_BAR;
    for (;;) {
        const bool has_next = S.next(ui + 1, nxt);
        const char* nA = has_next ? PG8_UA(nxt) : cA; const char* nB = has_next ? PG8_UB(nxt) : cB;
        for (int t = 0; t < nt; t += 2) {
            const bool last = (t == nt - 2);
            const char* a1 = cA + (size_t)(t + 1) * kstep;
            const char* a2 = last ? nA : cA + (size_t)(t + 2) * kstep; const char* b2 = last ? nB : cB + (size_t)(t + 2) * kstep;
            const char* a3 = a2 + kstep; const char* b3 = b2 + kstep;
            PG8_LDB(B0, 0, 0); PG8_LDB(B1, 0, 1); PG8_SCHED; PG8_LDA(At, 0, 0); PG8_STAGE(PG8_SA(1, 1), a1 + hstepA, voffA);
            PG8_WAIT_V(8); PG8_WAIT_L(0); PG8_BAR; PG8_MMA(0, 0, At, B0); PG8_MMA(0, 1, At, B1); PG8_BAR; PG8_SCHED;
            PG8_LDA(At, 0, 1); PG8_STAGE(PG8_SB(0, 0), b2, voffB); PG8_STAGE(PG8_SB(0, 1), b2 + hstepB, voffB); PG8_STAGE(PG8_SA(0, 0), a2, voffA);
            PG8_WAIT_V(8); PG8_WAIT_L(0); PG8_BAR; PG8_MMA(1, 0, At, B0); PG8_MMA(1, 1, At, B1); PG8_BAR; PG8_SCHED;
            PG8_LDB(B0, 1, 0); PG8_LDB(B1, 1, 1); PG8_SCHED; PG8_LDA(At, 1, 0); PG8_STAGE(PG8_SA(0, 1), a2 + hstepA, voffA);
            PG8_WAIT_V(8); PG8_WAIT_L(0); PG8_BAR; PG8_MMA(0, 0, At, B0); PG8_MMA(0, 1, At, B1); PG8_BAR; PG8_SCHED;
            PG8_LDA(At, 1, 1); PG8_STAGE(PG8_SB(1, 0), b3, voffB); PG8_STAGE(PG8_SB(1, 1), b3 + hstepB, voffB); PG8_STAGE(PG8_SA(1, 0), a3, voffA);
            PG8_WAIT_V(8); PG8_WAIT_L(0); PG8_BAR; PG8_MMA(1, 0, At, B0); PG8_MMA(1, 1, At, B1); PG8_BAR; PG8_SCHED;
        }
        if constexpr (ALIGN_EPI) { if (wr == 0) PG8_BAR; }
        E.template operator()<MT>(acc, cur, wr, wc, fr, fq);
        if (!has_next) break;
#pragma unroll
        for (int a = 0; a < 2; ++a)
#pragma unroll
            for (int b = 0; b < 2; ++b)
#pragma unroll
                for (int m = 0; m < MT; ++m)
#pragma unroll
                    for (int n = 0; n < 2; ++n) acc[a][b][m][n] = (f32x4){0.f, 0.f, 0.f, 0.f};
        cur = nxt; cA = nA; cB = nB; ++ui;
        if constexpr (ALIGN_EPI) { if (wr == 1) PG8_BAR; }
    }
    PG8_WAIT_V(0);
    if constexpr (!ALIGN_EPI) { if (wr == 0) PG8_BAR; }
    PG8_BAR;
#undef PG8_SA
#undef PG8_SB
#undef PG8_STAGE
#undef PG8_LDA
#undef PG8_LDB
#undef PG8_MMA
#undef PG8_WAIT_V
#undef PG8_WAIT_L
#undef PG8_BAR
#undef PG8_SCHED
#undef PG8_UA
#undef PG8_UB
}
}
constexpr int NWAVES = 8;
constexpr int LDS_BYTES = 163840;
constexpr int MISC_OFF = LDS_BYTES - 512;
struct Args { const float* in[31]; float* out; unsigned char* ws; int ph_lo, ph_hi; };
enum { I_XP = 0, I_XS, I_C, I_CK, I_CV, I_SC, I_SN, I_SM, I_CCTX, I_WADA, I_BADA, I_GNORM, I_F1W1, I_F1W3, I_F1W2, I_F2W1, I_F2W3, I_F2W2, I_WIN, I_BGATE, I_GQN, I_GKN,
       I_LQ1, I_LK1, I_LQ2, I_LK2, I_GSUB, I_GMH, I_WBRM, I_WBRD, I_WOUT };
#define LDS_WAIT() asm volatile("s_waitcnt lgkmcnt(0)" ::: "memory")
typedef const unsigned char __attribute__((address_space(4)))* KP;
#define AIN(i) (*(const float* const __attribute__((address_space(4)))*)(kp + 8 * (i)))
#define AOUT (*(float* const __attribute__((address_space(4)))*)(kp + 248))
#define AWS (*(unsigned char* const __attribute__((address_space(4)))*)(kp + 256))
static_assert(sizeof(Args) == 272, "Args layout");

struct TrItem { const float* W; bf16_t* WT; float* swo; int ldw, ncol0, k0, ldk, drow0, swn; bool rowperm; };
__device__ __forceinline__ TrItem tr_decode(KP kp, int set, int it) {
    constexpr int I_UP = 16 * 88, I_IN = 16 * 288, I_DN = 44 * 32, I_SQ = 16 * 32;
    float* swb = (float*)(AWS + WS_MISC + MISC_SW);
    TrItem t; t.swo = nullptr; t.swn = 0; t.rowperm = false;
    int r = it;
    if (set == 1) {
        if (r < I_IN) {
            const int kb = r / 288, nb = r % 288, f0 = 32 * nb, src = f0 < 4096 ? f0 : f0 + 16, fw = f0 & 255, grp = f0 >> 10;
            t.W = AIN(I_WIN); t.ldw = DIN; t.ncol0 = src; t.k0 = 64 * kb; t.WT = (bf16_t*)(AWS + WS_WIN); t.ldk = DM; t.drow0 = (f0 & ~255) + 128 * ((fw >> 5) & 1) + 32 * (fw >> 6);
            t.rowperm = !(grp == 4 || grp == 5); t.swo = swb + SW_C; t.swn = NWIN; return t; }
        r -= I_IN;
        { const int kb = r / 32, nb = r % 32;
          t.W = AIN(I_F1W2); t.ldw = DM; t.ncol0 = 32 * nb; t.k0 = 64 * kb; t.WT = (bf16_t*)(AWS + WS_W2A); t.ldk = FF; t.drow0 = 32 * nb; return t; }
    }
    if (r < 2 * I_UP) {
        const int which = r / I_UP; r -= which * I_UP;
        const int kb = r / 88, nb = r % 88, n0 = 32 * nb;
        t.W = AIN(set == 0 ? (which == 0 ? I_F1W1 : I_F1W3) : (which == 0 ? I_F2W1 : I_F2W3)); t.ldw = FF; t.ncol0 = n0; t.k0 = 64 * kb;
        t.WT = (bf16_t*)(AWS + (set ? WS_W13B : WS_W13A)); t.ldk = DM; t.drow0 = 256 * (n0 >> 7) + (which ? 128 : 0) + (n0 & 127);
        if (set == 2) { t.swo = swb + SW_F; t.swn = 5632; }
        return t; }
    r -= 2 * I_UP;
    if (r < I_DN) {
        const int kb = r / 32, nb = r % 32;
        t.W = AIN(I_F2W2); t.ldw = DM; t.ncol0 = 32 * nb; t.k0 = 64 * kb; t.WT = (bf16_t*)(AWS + WS_W2B); t.ldk = FF; t.drow0 = 32 * nb; return t; }
    r -= I_DN;
    { const int which = r / I_SQ; r -= which * I_SQ; const int kb = r / 32, nb = r % 32;
      t.W = AIN(which == 0 ? I_WBRM : which == 1 ? I_WBRD : I_WOUT); t.ldw = DM; t.ncol0 = 32 * nb; t.k0 = 64 * kb; t.WT = (bf16_t*)(AWS + (which == 2 ? WS_WOUT : WS_WBR)); t.ldk = DM;
      t.drow0 = (which == 1 ? 1024 : 0) + 32 * nb; return t; }
}
__device__ __forceinline__ void tr_load(const TrItem& t, float (&wreg)[32], int lane) {
#pragma unroll
    for (int i = 0; i < 32; ++i) wreg[i] = __builtin_nontemporal_load(&t.W[(size_t)(t.k0 + 2 * i + (lane >> 5)) * t.ldw + t.ncol0 + (lane & 31)]);
}
__device__ __forceinline__ void p0_transposes(KP kp, LAS unsigned char* lds, int wave, int lane, int gw, int NGW, int set, bool sw_on = true) {
    LAS float* scr = (LAS float*)(lds + wave * 16384);
    constexpr int I_UP = 16 * 88, I_DN = 44 * 32, I_IN = 16 * 288, I_SQ = 16 * 32;
    const int nitems = set == 0 ? 2 * I_UP : set == 1 ? I_IN + I_DN : 2 * I_UP + I_DN + 3 * I_SQ;
    LAS float* shl = (LAS float*)(lds + 131072);
    if (set != 0) { const float* mods = (const float*)(AWS + WS_MISC + MISC_MODS);
        for (int i = wave * 64 + lane; i < 3 * DM; i += NWAVES * 64) shl[i] = mods[((i >> 10) * NMOD + 3 * set) * DM + (i & 1023)];
        __syncthreads(); }
    if (gw >= nitems) return;
    float wreg[32];
    TrItem t = tr_decode(kp, set, gw);
    tr_load(t, wreg, lane);
    for (int it = gw; it < nitems; it += NGW) {
#pragma unroll
        for (int i = 0; i < 32; ++i) scr[(2 * i + (lane >> 5)) * 33 + (lane & 31)] = wreg[i];
        LDS_WAIT(); asm volatile("" ::: "memory");
        const TrItem c = t;
        if (it + NGW < nitems) { t = tr_decode(kp, set, it + NGW); tr_load(t, wreg, lane); }
        if (c.swo && sw_on) {
            const int n = lane & 31, kh = lane >> 5;
            float d0 = 0.f, d1 = 0.f, d2 = 0.f;
#pragma unroll 2
            for (int kk = 0; kk < 32; kk += 4) { const int k = kh * 32 + kk;
                const f32x4 h0 = *(const LAS f32x4*)(shl + c.k0 + k), h1 = *(const LAS f32x4*)(shl + DM + c.k0 + k), h2 = *(const LAS f32x4*)(shl + 2 * DM + c.k0 + k);
#pragma unroll
                for (int e = 0; e < 4; ++e) { const float w = scr[(k + e) * 33 + n]; d0 += w * h0[e]; d1 += w * h1[e]; d2 += w * h2[e]; } }
            d0 += __shfl_xor(d0, 32); d1 += __shfl_xor(d1, 32); d2 += __shfl_xor(d2, 32);
            if (lane < 32) { const int nd = c.rowperm ? 16 * ((n >> 2) & 1) + 4 * (n >> 3) + (n & 3) : n;
                atomicAdd(c.swo + c.drow0 + nd, d0); atomicAdd(c.swo + c.swn + c.drow0 + nd, d1); atomicAdd(c.swo + 2 * c.swn + c.drow0 + nd, d2); }
        }
        const int cc = lane & 7;
#pragma unroll
        for (int j = 0; j < 4; ++j) { const int n = (lane >> 3) + 8 * j; const LAS float* sp = scr + (8 * cc) * 33 + n;
            u32x4 o; o.x = pk2(sp[0 * 33], sp[1 * 33]); o.y = pk2(sp[2 * 33], sp[3 * 33]); o.z = pk2(sp[4 * 33], sp[5 * 33]); o.w = pk2(sp[6 * 33], sp[7 * 33]);
            const int nd = c.rowperm ? 16 * ((n >> 2) & 1) + 4 * (n >> 3) + (n & 3) : n;
            *(u32x4*)(c.WT + (size_t)(c.drow0 + nd) * c.ldk + c.k0 + 8 * cc) = o; }
        LDS_WAIT(); asm volatile("" ::: "memory");
    }
}
__device__ __forceinline__ void p0_misc(KP kp, int gt, int NGT) {
    {
      for (int i0 = gt; i0 < 262144; i0 += 3 * NGT) {
          f32x4 vk[3], vv[3];
#pragma unroll
          for (int q = 0; q < 3; ++q) { const int i = i0 + q * NGT; if (i < 262144) { vk[q] = __builtin_nontemporal_load((const f32x4*)AIN(I_CK) + i); vv[q] = __builtin_nontemporal_load((const f32x4*)AIN(I_CV) + i); } }
#pragma unroll
          for (int q = 0; q < 3; ++q) { const int i = i0 + q * NGT; if (i < 262144) {
              u32x2 ok, ov; ok.x = pk2(vk[q][0], vk[q][1]); ok.y = pk2(vk[q][2], vk[q][3]); ov.x = pk2(vv[q][0], vv[q][1]); ov.y = pk2(vv[q][2], vv[q][3]);
              ((u32x2*)(AWS + WS_CK))[i] = ok; ((u32x2*)(AWS + WS_CV))[i] = ov; } } }
      bf16_t* wg = (bf16_t*)(AWS + WS_WIN) + (size_t)9216 * DM;
      for (int i = gt; i < 32 * 1024; i += NGT) { const int p_ = i >> 10, k = i & 1023; const float w = AIN(I_WIN)[(size_t)k * DIN + 4096 + (p_ & 15)]; const unsigned hi = f2bf(w);
          wg[i] = (bf16_t)(p_ < 16 ? hi : f2bf(w - bf2f(hi)));
          if (p_ < 16) {
              const float* mods = (const float*)(AWS + WS_MISC + MISC_MODS); float* swc = (float*)(AWS + WS_MISC + MISC_SW) + SW_C;
#pragma unroll
              for (int mi = 0; mi < 3; ++mi) { const float d = wave_sum(w * mods[(mi * NMOD + 3) * DM + k]); if ((i & 63) == 0) atomicAdd(swc + mi * NWIN + 9216 + p_, d); } } }
      for (int i = gt; i < 224 * 1024 / 8; i += NGT) ((u32x4*)(wg + 32 * 1024))[i] = (u32x4){0u, 0u, 0u, 0u};
      float* rope = (float*)(AWS + WS_MISC + MISC_ROPE);
      for (int i = gt; i < 1024; i += NGT) { const int pos = i >> 4, fi = i & 15;
          double th = 1.0; for (int q = 0; q < fi; ++q) th *= 0.56234132519034908;
          double sn = 0.0, cs = 0.0, term = 1.0;
          for (int q = 0; q < 24; ++q) { if (q & 1) sn += ((q >> 1) & 1) ? -term : term; else cs += ((q >> 1) & 1) ? -term : term; term *= th / (double)(q + 1); }
          double rc = 1.0, rs = 0.0, bc = cs, bs = sn;
          for (int p = pos; p > 0; p >>= 1) { if (p & 1) { const double t = rc * bc - rs * bs; rs = rc * bs + rs * bc; rc = t; } const double t2 = bc * bc - bs * bs; bs = 2.0 * bc * bs; bc = t2; }
          rope[2 * i] = (float)rc; rope[2 * i + 1] = (float)rs; }
    }
}
__device__ __forceinline__ void p0_prologue(KP kp, LAS unsigned char* lds, int tid, int wave, int lane, int vcu, int G) {
    LAS float* sc = (LAS float*)(lds + 65536);
    LAS float* part = (LAS float*)(lds + 65536 + 24576);
    for (int i = tid; i < 3 * 1024; i += 512) { const int v = i >> 10, k = i & 1023; const float x = v == 0 ? AIN(I_CCTX)[k] : AIN(I_C)[(v - 1) * 1024 + k]; sc[i] = siluf_(x); }
    if (tid < 64) { sc[3072 + tid] = 0.f; sc[3072 + 1024 + tid] = 0.f; sc[3072 + 2048 + tid] = 0.f; }
    { float* swz = (float*)(AWS + WS_MISC + MISC_SW); for (int i = SW_C + vcu * 512 + tid; i < SW_END; i += G * 512) swz[i] = 0.f; }
    __syncthreads();
    if (wave < 4) p0_transposes(kp, lds, wave, lane, vcu * 4 + wave, G * 4, 0);
    for (int cb = blockIdx.x; cb < 256; cb += G) {
        if (wave >= 4) {
            const int w4 = wave - 4, rsub = lane / 9, c4 = lane % 9;
            f32x4 acc[3]; acc[0] = acc[1] = acc[2] = (f32x4){0.f, 0.f, 0.f, 0.f};
            const char* wbase = (const char*)(AIN(I_WADA) + (size_t)(256 * w4) * (NMOD * DM) + 36 * cb);
            unsigned woff = (unsigned)((rsub * (NMOD * DM) + 4 * c4) * 4); asm volatile("" : "+v"(woff));
            unsigned wlast = rsub < 4 ? woff : (unsigned)(((255 - 252) * (NMOD * DM) + 4 * c4) * 4); asm volatile("" : "+v"(wlast));
            const LAS float* slast = rsub < 4 ? sc + 256 * w4 + rsub + 252 : sc + 3072;
            if (lane < 63) {
#define MODS_BATCH(half) do { f32x4 w[13]; \
                    _Pragma("unroll") for (int it = 0; it < 13; ++it) { const int j = it + 13 * (half); if (j <= 36) \
                        w[it] = __builtin_nontemporal_load((const f32x4*)(wbase + (j < 36 ? woff : wlast) + (unsigned)(7 * (j < 36 ? j : 36) * (NMOD * DM * 4)))); } \
                    _Pragma("unroll") for (int it = 0; it < 13; ++it) { const int j = it + 13 * (half); const LAS float* s_ = j < 36 ? sc + 256 * w4 + rsub + 7 * j : slast; \
                        if (j <= 36) { acc[0] += w[it] * s_[0]; acc[1] += w[it] * s_[1024]; acc[2] += w[it] * s_[2048]; } } } while (0)
                MODS_BATCH(0); __builtin_amdgcn_sched_barrier(0); MODS_BATCH(1); __builtin_amdgcn_sched_barrier(0); MODS_BATCH(2);
#undef MODS_BATCH
#pragma unroll
                for (int v = 0; v < 3; ++v)
#pragma unroll
                    for (int e = 0; e < 4; ++e) part[(w4 * 7 + rsub) * 108 + v * 36 + 4 * c4 + e] = acc[v][e];
            }
        }
        __syncthreads();
        if (tid < 108) { float s_ = 0.f; for (int p_ = 0; p_ < 28; ++p_) s_ += part[p_ * 108 + tid];
            const int v = tid / 36, col = 36 * cb + tid % 36;
            ((float*)(AWS + WS_MISC + MISC_MODS))[v * (NMOD * DM) + col] = s_ + AIN(I_BADA)[col]; }
        __syncthreads();
    }
}
__device__ __forceinline__ void p1_pass(KP kp, int tid, int wave, int lane, int vcu, int G) {
    const float* mods = (const float*)(AWS + WS_MISC + MISC_MODS);
    bf16_t* HH = (bf16_t*)(AWS + WS_HH);
    float* rowss = (float*)(AWS + WS_CTL) + CW_ROWSS;
    const int gw = vcu * NWAVES + wave, NGW = G * NWAVES;
    f32x4 gn[4];
#pragma unroll
    for (int j = 0; j < 4; ++j) gn[j] = ((const f32x4*)AIN(I_GNORM))[lane + 64 * j];
    const bf16_t* Wt = (const bf16_t*)(AWS + WS_W13A); float* swo = (float*)(AWS + WS_MISC + MISC_SW) + SW_A; constexpr int NR = 5632;
    f32x4 sh[3][4];
#pragma unroll
    for (int mi = 0; mi < 3; ++mi) { const float* p_ = mods + (mi * NMOD) * DM + 8 * lane; sh[mi][0] = *(const f32x4*)p_; sh[mi][1] = *(const f32x4*)(p_ + 4); sh[mi][2] = *(const f32x4*)(p_ + 512); sh[mi][3] = *(const f32x4*)(p_ + 516); }
    u32x4 wa[3], wb[3]; int rowb = gw;
#define P1_SW_LOAD() _Pragma("unroll") for (int q = 0; q < 3; ++q) { const int row = rowb + q * NGW; wa[q] = (u32x4){0u, 0u, 0u, 0u}; wb[q] = wa[q]; \
        if (row < NR) { wa[q] = *(const u32x4*)(Wt + (size_t)row * DM + 8 * lane); wb[q] = *(const u32x4*)(Wt + (size_t)row * DM + 512 + 8 * lane); } }
    P1_SW_LOAD()
    for (int m0 = gw; m0 < MROWS; m0 += 3 * NGW) {
        f32x4 v[3][4], sc[3][4];
#pragma unroll
        for (int q = 0; q < 3; ++q) { const int m = m0 + q * NGW; if (m < MROWS) { const float* src = m < NCTX ? AIN(I_XP) + (size_t)m * DM : AIN(I_XS) + (size_t)(m - NCTX) * DM;
            const int mi = m < NCTX ? 0 : 1 + ((m - NCTX) >> 10);
#pragma unroll
            for (int j = 0; j < 4; ++j) { v[q][j] = ((const f32x4*)src)[lane + 64 * j]; sc[q][j] = ((const f32x4*)(mods + (mi * NMOD + 1) * DM))[lane + 64 * j]; } } }
#pragma unroll
        for (int q = 0; q < 3; ++q) { const int m = m0 + q * NGW; if (m < MROWS) {
            float ss = 0.f;
#pragma unroll
            for (int j = 0; j < 4; ++j) { ss += (v[q][j][0] * v[q][j][0] + v[q][j][1] * v[q][j][1]) + (v[q][j][2] * v[q][j][2] + v[q][j][3] * v[q][j][3]);
                const f32x4 h = v[q][j] * (gn[j] * (sc[q][j] + 1.0f));
                u32x2 o; o.x = pk2(h[0], h[1]); o.y = pk2(h[2], h[3]);
                ((u32x2*)(HH + (size_t)m * DM))[lane + 64 * j] = o; }
            ss = wave_sum(ss); if (lane == 0) rowss[m] = ss; } }
    }
    if (gw == 0) { const float q1 = wave_sum(AIN(I_LQ1)[lane] * AIN(I_LK1)[lane]), q2 = wave_sum(AIN(I_LQ2)[lane] * AIN(I_LK2)[lane]); if (lane == 0) *(float*)(AWS + WS_MISC + MISC_LAM) = __expf(q1) - __expf(q2) + 0.2f; }
    { float* gs = (float*)(AWS + WS_MISC + MISC_GS);
      for (int i = vcu * 512 + tid; i < 9 * DM; i += G * 512) { const int k = i / (3 * DM), mi = (i / DM) % 3, c = i % DM; gs[i] = AIN(I_GNORM)[k * DM + c] * (1.0f + mods[(mi * NMOD + 3 * k + 1) * DM + c]); } }
    for (;;) {
#pragma unroll
        for (int q = 0; q < 3; ++q) { const int row = rowb + q * NGW;
            const f32x4 w0 = {bflo(wa[q].x), bfhi(wa[q].x), bflo(wa[q].y), bfhi(wa[q].y)}, w1 = {bflo(wa[q].z), bfhi(wa[q].z), bflo(wa[q].w), bfhi(wa[q].w)}, w2 = {bflo(wb[q].x), bfhi(wb[q].x), bflo(wb[q].y), bfhi(wb[q].y)}, w3 = {bflo(wb[q].z), bfhi(wb[q].z), bflo(wb[q].w), bfhi(wb[q].w)};
            float d[3];
#pragma unroll
            for (int mi = 0; mi < 3; ++mi) { const f32x4 t = sh[mi][0] * w0 + sh[mi][1] * w1 + sh[mi][2] * w2 + sh[mi][3] * w3; d[mi] = wave_sum((t[0] + t[1]) + (t[2] + t[3])); }
            if (lane == 0 && row < NR) { swo[row] = d[0]; swo[NR + row] = d[1]; swo[2 * NR + row] = d[2]; } }
        rowb += 3 * NGW; if (rowb >= NR) break;
        P1_SW_LOAD()
    }
#undef P1_SW_LOAD
}
__device__ __forceinline__ void st8_wt(void* p, u32x2 v) { asm volatile("global_store_dwordx2 %0, %1, off sc1" :: "v"(p), "v"(v) : "memory"); }
__device__ __forceinline__ void hm_rows(KP kp, int pm, int pn, int z, int tid, int wave, int lane) {
    const bf16_t* HF = (const bf16_t*)(AWS + WS_HFB); const bf16_t* HB = HF + (size_t)MROWS * DM;
    const bf16_t* MOS = (const bf16_t*)(AWS + WS_R + R_MOS);
    bf16_t* AB = (bf16_t*)(AWS + WS_AB);
    unsigned* flg = (unsigned*)(AWS + WS_CTL) + CW_DFT + pm * 8;
    f32x4 gm[4];
#pragma unroll
    for (int j = 0; j < 4; ++j) gm[j] = ((const f32x4*)AIN(I_GMH))[lane + 64 * j];
    const int r0 = pm * 192 + (pn * 2 + z) * 24 + wave * 3;
    u32x2 f[3][4], b[3][4], o[3][4];
#pragma unroll
    for (int q = 0; q < 3; ++q) { const int m = r0 + q;
#pragma unroll
        for (int j = 0; j < 4; ++j) { f[q][j] = ((const u32x2*)(HF + (size_t)m * DM))[lane + 64 * j]; b[q][j] = ((const u32x2*)(HB + (size_t)m * DM))[lane + 64 * j]; o[q][j] = ((const u32x2*)(MOS + (size_t)m * DM))[lane + 64 * j]; } }
#pragma unroll
    for (int q = 0; q < 3; ++q) { const int m = r0 + q;
#pragma unroll
        for (int j = 0; j < 4; ++j) {
            f32x4 s = {bflo(f[q][j].x) + bflo(b[q][j].x), bfhi(f[q][j].x) + bfhi(b[q][j].x), bflo(f[q][j].y) + bflo(b[q][j].y), bfhi(f[q][j].y) + bfhi(b[q][j].y)};
            const float ss = wave_sum((s[0] * s[0] + s[1] * s[1]) + (s[2] * s[2] + s[3] * s[3]));
            const float rstd = rsqrtf(ss * (1.0f / 256.0f) + EPS);
            s = s * rstd * gm[j] * (f32x4){sigmoidf_(bflo(o[q][j].x)), sigmoidf_(bfhi(o[q][j].x)), sigmoidf_(bflo(o[q][j].y)), sigmoidf_(bfhi(o[q][j].y))};
            u32x2 w; w.x = pk2(s[0], s[1]); w.y = pk2(s[2], s[3]);
            st8_wt((u32x2*)(AB + (size_t)m * 2048) + lane + 64 * j, w); } }
    asm volatile("s_waitcnt vmcnt(0)" ::: "memory"); __syncthreads();
    if (tid < 64) {
        if (tid == 0) __hip_atomic_store(flg + pn * 2 + z, 1u, __ATOMIC_RELAXED, __HIP_MEMORY_SCOPE_AGENT);
        if (z == 0) { unsigned sp = 0u;
            for (;;) { const unsigned v = __hip_atomic_load(flg + (lane & 7), __ATOMIC_RELAXED, __HIP_MEMORY_SCOPE_AGENT);
                if (__builtin_amdgcn_ballot_w64(v == 0u) == 0ull || ++sp > (1u << 22)) break;
                __builtin_amdgcn_s_sleep(2); }
            __builtin_amdgcn_fence(__ATOMIC_ACQUIRE, "agent"); } }
    asm volatile("s_waitcnt vmcnt(0) lgkmcnt(0)" ::: "memory"); __syncthreads();
}
#define MFMA16(a, b, c) __builtin_amdgcn_mfma_f32_16x16x32_bf16((a), (b), (c), 0, 0, 0)
typedef short v4i16_t __attribute__((ext_vector_type(4)));
__device__ __forceinline__ s16x4 tr_read(LAS unsigned char* p) { return __builtin_bit_cast(s16x4, __builtin_amdgcn_ds_read_tr16_b64_v4i16((LAS v4i16_t*)p)); }
__device__ __forceinline__ bf16x8 cat8(s16x4 a, s16x4 b) { return (bf16x8){a[0], a[1], a[2], a[3], b[0], b[1], b[2], b[3]}; }
__device__ __forceinline__ bf16x8 pack8(f32x4 a, f32x4 b) { u32x4 w; w.x = pg8::cvt_pk_bf16(a[0], a[1]); w.y = pg8::cvt_pk_bf16(a[2], a[3]); w.z = pg8::cvt_pk_bf16(b[0], b[1]); w.w = pg8::cvt_pk_bf16(b[2], b[3]); return __builtin_bit_cast(bf16x8, w); }

__device__ __forceinline__ float max3f(float a, float b, float c) { float r; asm("v_max3_f32 %0, %1, %2, %3" : "=v"(r) : "v"(a), "v"(b), "v"(c)); return r; }
__device__ __forceinline__ float xlane_max(float x) { x = fmaxf(x, __shfl_xor(x, 16)); return fmaxf(x, __shfl_xor(x, 32)); }
__device__ __forceinline__ float xlane_sum(float x) { x += __shfl_xor(x, 16); return x + __shfl_xor(x, 32); }
constexpr int AT_ROW = 288, AT_TILE = 64 * AT_ROW, AT_BUF = 2 * AT_TILE;
__device__ __forceinline__ void attn_unit(KP kp, LAS unsigned char* lds, int lat, int b, int h, int qb, float lam, int tid, int wave, int lane) {
    const unsigned char* R = AWS + WS_R;
    const bf16_t* DQ = (const bf16_t*)(R + R_DQ); const bf16_t* DK = (const bf16_t*)(R + R_DK); const bf16_t* DV = (const bf16_t*)(R + R_DV);
    const bf16_t* CK = (const bf16_t*)(AWS + WS_CK); const bf16_t* CV = (const bf16_t*)(AWS + WS_CV);
    const int r0 = lat ? NCTX + b * 1024 : b * 256, nown = lat ? 1024 : 256, ntile = lat ? 24 : 4;
    const int fr = lane & 15, g = lane >> 4;
    const int qrow = r0 + qb * 128 + wave * 16 + fr;
    bf16x8 qf[2][2];
    { const char* qb_ = (const char*)(DQ + (size_t)(r0 + qb * 128 + wave * 16) * DM + h * 128); const unsigned qo_ = (unsigned)(fr * (DM * 2) + g * 16);
      asm volatile("global_load_dwordx4 %0, %4, %5\n\tglobal_load_dwordx4 %1, %4, %5 offset:64\n\tglobal_load_dwordx4 %2, %4, %5 offset:128\n\tglobal_load_dwordx4 %3, %4, %5 offset:192"
          : "=&v"(qf[0][0]), "=&v"(qf[0][1]), "=&v"(qf[1][0]), "=&v"(qf[1][1]) : "v"(qo_), "s"(qb_) : "memory"); }
    float mx[2] = {0.f, 0.f}, ls[2] = {0.f, 0.f};
    f32x4 O[2][8];
#pragma unroll
    for (int c = 0; c < 2; ++c)
#pragma unroll
        for (int vb = 0; vb < 8; ++vb) O[c][vb] = (f32x4){0.f, 0.f, 0.f, 0.f};
    u32x4 kreg[2][2], vreg[2][2];
    const int key0 = tid >> 4, ch = tid & 15;
    const unsigned lo_at = (unsigned)(key0 * (DM * 2) + ch * 16), lo_at2 = lo_at + (unsigned)(32 * DM * 2);
#define AT_LOAD(kt, set) do { const int kb_ = (kt) * 64; const char* ks_; const char* vs_; \
        if (kb_ < nown) { ks_ = (const char*)(DK + (size_t)(r0 + kb_) * DM + h * 128); vs_ = (const char*)(DV + (size_t)(r0 + kb_) * DM + h * 128); } \
        else { ks_ = (const char*)(CK + (size_t)(b * 512 + kb_ - nown) * DM + h * 128); vs_ = (const char*)(CV + (size_t)(b * 512 + kb_ - nown) * DM + h * 128); } \
        asm volatile("global_load_dwordx4 %0, %4, %6\n\tglobal_load_dwordx4 %1, %4, %7\n\tglobal_load_dwordx4 %2, %5, %6\n\tglobal_load_dwordx4 %3, %5, %7" \
            : "=&v"(kreg[set][0]), "=&v"(vreg[set][0]), "=&v"(kreg[set][1]), "=&v"(vreg[set][1]) : "v"(lo_at), "v"(lo_at2), "s"(ks_), "s"(vs_) : "memory"); } while (0)
#define AT_WAIT(n, set) asm volatile("s_waitcnt vmcnt(" #n ")" : "+v"(kreg[set][0]), "+v"(vreg[set][0]), "+v"(kreg[set][1]), "+v"(vreg[set][1]) :: "memory")
#define AT_STORE(buf, set) do { _Pragma("unroll") for (int i_ = 0; i_ < 2; ++i_) { \
        *(LAS u32x4*)(lds + (buf) * AT_BUF + (key0 + 32 * i_) * AT_ROW + ch * 16) = kreg[set][i_]; *(LAS u32x4*)(lds + (buf) * AT_BUF + AT_TILE + (key0 + 32 * i_) * AT_ROW + ch * 16) = vreg[set][i_]; } } while (0)
    __syncthreads();
    AT_LOAD(0, 0); AT_LOAD(1, 1);
    AT_WAIT(4, 0); asm volatile("" : "+v"(qf[0][0]), "+v"(qf[0][1]), "+v"(qf[1][0]), "+v"(qf[1][1]));
    AT_STORE(0, 0); AT_LOAD(2, 0);
    __syncthreads();
    for (int kt0 = 0; kt0 < ntile; kt0 += 2)
#pragma unroll
    for (int ku = 0; ku < 2; ++ku) { const int kt = kt0 + ku;
        LAS unsigned char* Ks = lds + (kt & 1) * AT_BUF; LAS unsigned char* Vs = Ks + AT_TILE;
        f32x4 S[2][4];
#pragma unroll
        for (int c = 0; c < 2; ++c)
#pragma unroll
            for (int j = 0; j < 4; ++j) { const float ni = -mx[c]; S[c][j] = (f32x4){ni, ni, ni, ni};
#pragma unroll
                for (int s = 0; s < 2; ++s) { const bf16x8 kf = *(const LAS bf16x8*)(Ks + (16 * j + fr) * AT_ROW + (c * 64 + s * 32 + g * 8) * 2); S[c][j] = MFMA16(kf, qf[c][s], S[c][j]); } }
        float tl[2];
#pragma unroll
        for (int c = 0; c < 2; ++c) { float t = max3f(S[c][0][0], S[c][0][1], S[c][0][2]); t = max3f(t, S[c][0][3], S[c][1][0]); t = max3f(t, S[c][1][1], S[c][1][2]); t = max3f(t, S[c][1][3], S[c][2][0]);
            t = max3f(t, S[c][2][1], S[c][2][2]); t = max3f(t, S[c][2][3], S[c][3][0]); t = max3f(t, S[c][3][1], S[c][3][2]); tl[c] = max3f(t, S[c][3][3], t); }
        const bool first = (kt == 0);
        if (first || __builtin_amdgcn_ballot_w64((tl[0] > 8.f) || (tl[1] > 8.f)) != 0ull) {
#pragma unroll
            for (int c = 0; c < 2; ++c) { const float tmf = xlane_max(tl[c]); const float d = first ? tmf : fmaxf(tmf, 0.f);
                if (!first) { const float alpha = __builtin_amdgcn_exp2f(-d); ls[c] *= alpha;
#pragma unroll
                    for (int vb = 0; vb < 8; ++vb) O[c][vb] = O[c][vb] * alpha; }
                mx[c] += d;
#pragma unroll
                for (int j = 0; j < 4; ++j) S[c][j] = S[c][j] - d; }
        }
        bf16x8 pb[2][2];
#pragma unroll
        for (int c = 0; c < 2; ++c) { float rs = 0.f;
#pragma unroll
            for (int j = 0; j < 4; ++j)
#pragma unroll
                for (int e = 0; e < 4; ++e) { S[c][j][e] = __builtin_amdgcn_exp2f(S[c][j][e]); rs += S[c][j][e]; }
            ls[c] += rs;
            pb[c][0] = pack8(S[c][0], S[c][1]); pb[c][1] = pack8(S[c][2], S[c][3]); }
#pragma unroll
        for (int b2 = 0; b2 < 2; ++b2) {
            LAS unsigned char* vp = Vs + (32 * b2 + 4 * g + (fr >> 2)) * AT_ROW + (4 * (fr & 3)) * 2;
#pragma unroll
            for (int vb = 0; vb < 8; ++vb) { const bf16x8 vf = cat8(tr_read(vp + vb * 32), tr_read(vp + 16 * AT_ROW + vb * 32));
                O[0][vb] = MFMA16(vf, pb[0][b2], O[0][vb]); O[1][vb] = MFMA16(vf, pb[1][b2], O[1][vb]); }
        }
        if (kt + 1 < ntile) { if (kt + 2 < ntile) AT_WAIT(4, (ku + 1) & 1); else AT_WAIT(0, (ku + 1) & 1); AT_STORE((kt + 1) & 1, (ku + 1) & 1); }
        __syncthreads();
        if (kt + 3 < ntile) AT_LOAD(kt + 3, (ku + 1) & 1);
    }
#undef AT_LOAD
#undef AT_WAIT
#undef AT_STORE
    float inv[2];
#pragma unroll
    for (int c = 0; c < 2; ++c) inv[c] = __builtin_amdgcn_rcpf(xlane_sum(ls[c]));
    const float i0 = inv[0], i1 = lam * inv[1];
    float ss = 0.f;
#pragma unroll
    for (int vb = 0; vb < 8; ++vb) { O[0][vb] = O[0][vb] * i0 - O[1][vb] * i1; ss += (O[0][vb][0] * O[0][vb][0] + O[0][vb][1] * O[0][vb][1]) + (O[0][vb][2] * O[0][vb][2] + O[0][vb][3] * O[0][vb][3]); }
    ss = xlane_sum(ss);
    const float rstd = rsqrtf(ss * (1.0f / 128.0f) + EPS) * 0.8f;
    bf16_t* AB = (bf16_t*)(AWS + WS_AB);
#pragma unroll
    for (int vb = 0; vb < 8; ++vb) O[1][vb] = *(const f32x4*)(AIN(I_GSUB) + 16 * vb + 4 * g);
#pragma unroll
    for (int vb = 0; vb < 8; ++vb) { const f32x4 o = O[0][vb] * rstd * O[1][vb];
        u32x2 w; w.x = pk2(o[0], o[1]); w.y = pk2(o[2], o[3]);
        *(u32x2*)(AB + (size_t)qrow * 2048 + 1024 + h * 128 + 16 * vb + 4 * g) = w; }
}

constexpr int ML_KROW = 544, ML_VROW = 144;
constexpr int ML_K = 0, ML_V = 128 * ML_KROW  , ML_VW = ML_V + 128 * ML_VROW  , ML_CT = ML_VW + 128 * ML_VROW  , ML_B = ML_CT + 64 * ML_KROW  , ML_E = ML_B + 4096, ML_PM = ML_E + 4096, ML_N = ML_PM + 4096, ML_W = ML_N + 1024, ML_END = ML_W + 512;
static_assert(ML_END <= MISC_OFF, "mLSTM LDS map");
__device__ __forceinline__ void mlstm_unit(KP kp, LAS unsigned char* lds, int lat, int b, int h, int dir, int vs, int tid, int wave, int lane) {
    const unsigned char* R = AWS + WS_R;
    const bf16_t* MQ = (const bf16_t*)(R + R_MQ); const bf16_t* MK = (const bf16_t*)(R + R_MK); const bf16_t* MV = (const bf16_t*)(R + R_MV);
    const float* Gt = (const float*)(AWS + WS_G);
    bf16_t* HO = (bf16_t*)(AWS + WS_HFB) + (size_t)dir * MROWS * DM;
    const int r0 = lat ? NCTX + b * 1024 : b * 256, nc = lat ? 8 : 2;
    const int fr = lane & 15, g = lane >> 4;
    LAS float* Bc = (LAS float*)(lds + ML_B); LAS float* Ec = (LAS float*)(lds + ML_E); LAS float* Pm = (LAS float*)(lds + ML_PM);
    LAS float* Nv = (LAS float*)(lds + ML_N); LAS float* Wv = (LAS float*)(lds + ML_W);
    u32x4 kpre[8], vpre[2]; bf16x8 qf[8];
    const int krow0 = tid >> 5, kch = tid & 31, vrow0 = tid >> 3, vch = tid & 7;
#define ML_OROW(cb_, row_) (r0 + (dir ? (cb_) + 127 - (row_) : (cb_) + (row_)))
#define ML_PREFETCH_KV(k_) do { const int cb_ = 128 * (dir ? nc - 1 - (k_) : (k_)); \
        const char* kb_ = (const char*)MK + ((size_t)(r0 + cb_) * DM + h * 256) * 2; const char* vb_ = (const char*)MV + ((size_t)(r0 + cb_) * DM + h * 256 + vs * 64) * 2; \
        unsigned ko_ = (unsigned)((dir ? 127 - krow0 : krow0) * (DM * 2) + kch * 16), vo_ = (unsigned)((dir ? 127 - vrow0 : vrow0) * (DM * 2) + vch * 16); asm volatile("" : "+v"(ko_), "+v"(vo_)); \
        _Pragma("unroll") for (int i_ = 0; i_ < 8; ++i_) kpre[i_] = *(const u32x4*)(kb_ + (dir ? ko_ - (unsigned)(i_ * 16 * DM * 2) : ko_ + (unsigned)(i_ * 16 * DM * 2))); \
        _Pragma("unroll") for (int i_ = 0; i_ < 2; ++i_) vpre[i_] = *(const u32x4*)(vb_ + (dir ? vo_ - (unsigned)(i_ * 64 * DM * 2) : vo_ + (unsigned)(i_ * 64 * DM * 2))); } while (0)
#define ML_PREFETCH_Q(k_) do { const int cb_ = 128 * (dir ? nc - 1 - (k_) : (k_)); \
        const char* qb_ = (const char*)MQ + ((size_t)(r0 + cb_) * DM + h * 256) * 2; unsigned qo_ = (unsigned)((dir ? 127 - (16 * wave + fr) : 16 * wave + fr) * (DM * 2) + g * 16); asm volatile("" : "+v"(qo_)); \
        _Pragma("unroll") for (int ks_ = 0; ks_ < 8; ++ks_) qf[ks_] = *(const bf16x8*)(qb_ + qo_ + ks_ * 64); } while (0)
    ML_PREFETCH_KV(0); ML_PREFETCH_Q(0);
    __syncthreads();
    if (wave < nc) {
        const int k = wave, cb = 128 * (dir ? nc - 1 - k : k), t0 = 2 * lane;
        const int rowA = ML_OROW(cb, t0), rowB = ML_OROW(cb, t0 + 1);
        constexpr float L2E = 1.4426950408889634f;
        const float iA = Gt[(size_t)rowA * 16 + dir * 8 + h] * L2E, fA = Gt[(size_t)rowA * 16 + dir * 8 + 4 + h] * L2E;
        const float iB = Gt[(size_t)rowB * 16 + dir * 8 + h] * L2E, fB = Gt[(size_t)rowB * 16 + dir * 8 + 4 + h] * L2E;
        const float s1 = fA + fB; float incl = s1;
#pragma unroll
        for (int o = 1; o < 64; o <<= 1) { const float t = __shfl_up(incl, o); if (lane >= o) incl += t; }
        const float excl = incl - s1, bA = excl + fA, bB = excl + s1, eA = iA - bA, eB = iB - bB;
        const float p1 = fmaxf(eA, eB); float im = p1;
#pragma unroll
        for (int o = 1; o < 64; o <<= 1) { const float t = __shfl_up(im, o); if (lane >= o) im = fmaxf(im, t); }
        float ex = __shfl_up(im, 1); if (lane == 0) ex = -INFINITY;
        Bc[k * 128 + t0] = bA; Bc[k * 128 + t0 + 1] = bB; Ec[k * 128 + t0] = eA; Ec[k * 128 + t0 + 1] = eB;
        Pm[k * 128 + t0] = fmaxf(ex, eA); Pm[k * 128 + t0 + 1] = fmaxf(ex, p1);
    }
    const size_t sidx = (size_t)((b * 2 + dir) * 4 + h);
    float m_prev = lat ? AIN(I_SM)[sidx] * 1.4426950408889634f : 0.f;
    f32x4 Cacc[2][4], nacc[2];
    unsigned coff = (unsigned)((4 * g * 256 + fr) * 4); asm volatile("" : "+v"(coff));
#pragma unroll
    for (int dt = 0; dt < 2; ++dt) {
        nacc[dt] = (f32x4){0.f, 0.f, 0.f, 0.f};
        if (lat && fr == 0) nacc[dt] = *(const f32x4*)(AIN(I_SN) + sidx * 256 + 32 * wave + 16 * dt + 4 * g);
#pragma unroll
        for (int vt = 0; vt < 4; ++vt) {
            if (lat) {
                const char* cbase = (const char*)(AIN(I_SC) + (sidx * 256 + 32 * wave) * 256 + vs * 64);
#pragma unroll
                for (int e = 0; e < 4; ++e) Cacc[dt][vt][e] = *(const float*)(cbase + coff + (unsigned)(((16 * dt + e) * 256 + 16 * vt) * 4));
            } else Cacc[dt][vt] = (f32x4){0.f, 0.f, 0.f, 0.f};
        }
    }
    __syncthreads();
    for (int k = 0; k < nc; ++k) {
        const int cb = 128 * (dir ? nc - 1 - k : k);
        const int tq = 16 * wave + fr, qrow = ML_OROW(cb, tq);
        if (k > 0) __syncthreads();
        const float Mlast = fmaxf(m_prev, Pm[k * 128 + 127]), m_new = Bc[k * 128 + 127] + Mlast, decay = __builtin_amdgcn_exp2f(m_prev - Mlast);
#pragma unroll
        for (int i = 0; i < 8; ++i) *(LAS u32x4*)(lds + ML_K + (krow0 + 16 * i) * ML_KROW + kch * 16) = kpre[i];
#pragma unroll
        for (int i = 0; i < 2; ++i) { const int row = vrow0 + 64 * i; const float w = __builtin_amdgcn_exp2f(Ec[k * 128 + row] - Mlast);
            *(LAS u32x4*)(lds + ML_V + row * ML_VROW + vch * 16) = vpre[i];
            u32x4 x = vpre[i]; x.x = pg8::cvt_pk_bf16(bflo(x.x) * w, bfhi(x.x) * w); x.y = pg8::cvt_pk_bf16(bflo(x.y) * w, bfhi(x.y) * w); x.z = pg8::cvt_pk_bf16(bflo(x.z) * w, bfhi(x.z) * w); x.w = pg8::cvt_pk_bf16(bflo(x.w) * w, bfhi(x.w) * w);
            *(LAS u32x4*)(lds + ML_VW + row * ML_VROW + vch * 16) = x;
            if (vch == 0) Wv[row] = w; }
        const bool zero_state = !lat && k == 0;
        if (!zero_state) {
#pragma unroll
        for (int dt = 0; dt < 2; ++dt) {
#pragma unroll
            for (int vt = 0; vt < 4; ++vt) { u32x2 w; w.x = pg8::cvt_pk_bf16(Cacc[dt][vt][0], Cacc[dt][vt][1]); w.y = pg8::cvt_pk_bf16(Cacc[dt][vt][2], Cacc[dt][vt][3]);
                *(LAS u32x2*)(lds + ML_CT + (16 * vt + fr) * ML_KROW + (32 * wave + 16 * dt + 4 * g) * 2) = w; }
            if (fr == 0) *(LAS f32x4*)(Nv + 32 * wave + 16 * dt + 4 * g) = nacc[dt];
        } }
        if (k + 1 < nc) ML_PREFETCH_KV(k + 1);
        __syncthreads();
        const float Mt = fmaxf(m_prev, Pm[k * 128 + tq]), inter = __builtin_amdgcn_exp2f(m_prev - Mt);
        int wv_ = wave; asm volatile("" : "+s"(wv_));
        f32x4 S[8];
        float rsum = 0.f;
#pragma unroll
        for (int st = 0; st < 8; ++st) {
            S[st] = (f32x4){0.f, 0.f, 0.f, 0.f};
            if (st <= wv_) {
#pragma unroll
                for (int ks = 0; ks < 8; ++ks) { const bf16x8 kf = *(const LAS bf16x8*)(lds + ML_K + (16 * st + fr) * ML_KROW + (32 * ks + 8 * g) * 2); S[st] = MFMA16(kf, qf[ks], S[st]); }
                const f32x4 ev = *(const LAS f32x4*)(Ec + k * 128 + 16 * st + 4 * g);
#pragma unroll
                for (int e = 0; e < 4; ++e) { float wgt = __builtin_amdgcn_exp2f(ev[e] - Mt); if (st == wv_) wgt = (4 * g + e <= fr) ? wgt : 0.f; S[st][e] *= wgt; rsum += S[st][e]; }
                __builtin_amdgcn_sched_barrier(0);
            }
        }
        rsum = xlane_sum(rsum);
        bf16x8 pb[4];
#pragma unroll
        for (int b2 = 0; b2 < 4; ++b2) pb[b2] = pack8(S[2 * b2], S[2 * b2 + 1]);
        float qn = 0.f;
        if (!zero_state) {
#pragma unroll
        for (int ks = 0; ks < 8; ++ks) { const u32x4 qw = __builtin_bit_cast(u32x4, qf[ks]); const f32x4 n0 = *(const LAS f32x4*)(Nv + 32 * ks + 8 * g), n1 = *(const LAS f32x4*)(Nv + 32 * ks + 8 * g + 4);
            qn += (bflo(qw.x) * n0[0] + bfhi(qw.x) * n0[1]) + (bflo(qw.y) * n0[2] + bfhi(qw.y) * n0[3]) + (bflo(qw.z) * n1[0] + bfhi(qw.z) * n1[1]) + (bflo(qw.w) * n1[2] + bfhi(qw.w) * n1[3]); }
        qn = xlane_sum(qn); }
        f32x4 N1[4], N2[4];
#pragma unroll
        for (int vt = 0; vt < 4; ++vt) { N1[vt] = (f32x4){0.f, 0.f, 0.f, 0.f}; N2[vt] = (f32x4){0.f, 0.f, 0.f, 0.f}; }
#pragma unroll
        for (int b2 = 0; b2 < 4; ++b2) {
            if (2 * b2 <= wv_) {
                LAS unsigned char* vp = lds + ML_V + (32 * b2 + 4 * g + (fr >> 2)) * ML_VROW + (4 * (fr & 3)) * 2;
#pragma unroll
                for (int vt = 0; vt < 4; ++vt) { const bf16x8 vf = cat8(tr_read(vp + vt * 32), tr_read(vp + 16 * ML_VROW + vt * 32)); N1[vt] = MFMA16(vf, pb[b2], N1[vt]); }
            }
        }
        if (!zero_state) {
#pragma unroll
        for (int ks = 0; ks < 8; ++ks)
#pragma unroll
            for (int vt = 0; vt < 4; ++vt) { const bf16x8 cf = *(const LAS bf16x8*)(lds + ML_CT + (16 * vt + fr) * ML_KROW + (32 * ks + 8 * g) * 2); N2[vt] = MFMA16(cf, qf[ks], N2[vt]); if (vt == 3 && (ks & 1)) __builtin_amdgcn_sched_barrier(0); } }
        __builtin_amdgcn_sched_barrier(0);
        if (k + 1 < nc) ML_PREFETCH_Q(k + 1);
        {
            const float den = rsum + inter * qn, mt = Bc[k * 128 + tq] + Mt;
            const float rden = __builtin_amdgcn_rcpf(fmaxf(fabsf(den), __builtin_amdgcn_exp2f(-mt)));
#pragma unroll
            for (int vt = 0; vt < 4; ++vt) { const f32x4 o = (N1[vt] + N2[vt] * inter) * rden;
                u32x2 w; w.x = pk2(o[0], o[1]); w.y = pk2(o[2], o[3]);
                *(u32x2*)(HO + (size_t)qrow * DM + h * 256 + vs * 64 + 16 * vt + 4 * g) = w; }
        }
#pragma unroll
        for (int dt = 0; dt < 2; ++dt) { nacc[dt] = nacc[dt] * decay;
#pragma unroll
            for (int vt = 0; vt < 4; ++vt) Cacc[dt][vt] = Cacc[dt][vt] * decay; }
#pragma unroll
        for (int ks = 0; ks < 4; ++ks) {
            bf16x8 kf[2], wv[4];
#pragma unroll
            for (int dt = 0; dt < 2; ++dt) { LAS unsigned char* kp2 = lds + ML_K + (32 * ks + 8 * g + (fr >> 2)) * ML_KROW + (32 * wave + 16 * dt + 4 * (fr & 3)) * 2;
                kf[dt] = cat8(tr_read(kp2), tr_read(kp2 + 4 * ML_KROW)); }
#pragma unroll
            for (int vt = 0; vt < 4; ++vt) { LAS unsigned char* vp = lds + ML_VW + (32 * ks + 8 * g + (fr >> 2)) * ML_VROW + (16 * vt + 4 * (fr & 3)) * 2; wv[vt] = cat8(tr_read(vp), tr_read(vp + 4 * ML_VROW)); }
            bf16x8 wc;
            { const f32x4 w0 = *(const LAS f32x4*)(Wv + 32 * ks + 8 * g), w1 = *(const LAS f32x4*)(Wv + 32 * ks + 8 * g + 4);
              const f32x4 z0 = (fr == 0) ? w0 : (f32x4){0.f, 0.f, 0.f, 0.f}, z1 = (fr == 0) ? w1 : (f32x4){0.f, 0.f, 0.f, 0.f}; wc = pack8(z0, z1); }
#pragma unroll
            for (int dt = 0; dt < 2; ++dt) {
#pragma unroll
                for (int vt = 0; vt < 4; ++vt) Cacc[dt][vt] = MFMA16(kf[dt], wv[vt], Cacc[dt][vt]);
                nacc[dt] = MFMA16(kf[dt], wc, nacc[dt]);
            }
            __builtin_amdgcn_sched_barrier(0);
        }
        m_prev = m_new;
    }
#undef ML_OROW
#undef ML_PREFETCH_KV
#undef ML_PREFETCH_Q
    if (!lat) {
        char* oc = (char*)(AOUT + O_NEWC + sidx * 65536 + (size_t)(32 * wave) * 256 + vs * 64);
        unsigned ooff = (unsigned)((4 * g * 256 + fr) * 4); asm volatile("" : "+v"(ooff));
#pragma unroll
        for (int dt = 0; dt < 2; ++dt) {
#pragma unroll
            for (int vt = 0; vt < 4; ++vt)
#pragma unroll
                for (int e = 0; e < 4; ++e) __builtin_nontemporal_store(Cacc[dt][vt][e], (float*)(oc + ooff + (unsigned)(((16 * dt + e) * 256 + 16 * vt) * 4)));
            if (vs == 0 && fr == 0) *(f32x4*)(AOUT + O_NEWN + sidx * 256 + 32 * wave + 16 * dt + 4 * g) = nacc[dt];
        }
        if (vs == 0 && tid == 0) AOUT[O_NEWM + sidx] = m_prev * 0.6931471805599453f;
    }
}

constexpr int N_PHASES = 11;
#ifndef MK_N_LAUNCHES
#define MK_N_LAUNCHES 1
#endif
__global__ void __launch_bounds__(NWAVES * 64, 2) fwd_kernel(Args args_unused) {
    extern __shared__ __attribute__((aligned(16))) unsigned char lds_raw[];
    LAS unsigned char* lds = (LAS unsigned char*)lds_raw;
    volatile LAS unsigned* MISC = (volatile LAS unsigned*)(lds + MISC_OFF);
    const KP kp0 = (KP)__builtin_amdgcn_kernarg_segment_ptr();
    const int lo = *(const int __attribute__((address_space(4)))*)(kp0 + 264), hi = *(const int __attribute__((address_space(4)))*)(kp0 + 268);
    if (threadIdx.x < 64) MISC[threadIdx.x] = 0u;
    __syncthreads();
    const int wave_id = __builtin_amdgcn_readfirstlane((int)threadIdx.x >> 6);
    XcdBarrier bar; bar.bar = nullptr; bar.x = 0; bar.st = nullptr;
    if (hi - lo > 1) { KP kp = kp0; bar = xcd_barrier_post((unsigned*)(AWS + WS_CTL) + CW_BAR, MISC + 8); }
#ifndef PH_MASK
#define PH_MASK 0x7bf
#endif
#define IN(k) (((PH_MASK >> (k)) & 1) && lo <= (k) && (k) < hi)
#ifndef REPEAT_MASK
#define REPEAT_MASK 0
#endif
#ifndef FILL_REP4
#define FILL_REP4 1
#endif
#ifndef FILL_REP
#define FILL_REP 1
#endif
#define NREP(k) (((REPEAT_MASK >> (k)) & 1) ? 2 : 1)
#define SEAM2(k, kn) do { if (IN(k) && IN(kn)) xcd_barrier(bar, TIDX()); } while (0)
#define SEAM(k) SEAM2(k, (k) + 1)
#define TIDX() (wave_id * 64 + (int)__builtin_amdgcn_mbcnt_hi(~0u, __builtin_amdgcn_mbcnt_lo(~0u, 0u)))
#define PHASE_VARS KP kp = kp0; asm volatile("" : "+s"(kp)); int tid = TIDX(); asm volatile("" : "+v"(tid)); const int lane = tid & 63, wave = __builtin_amdgcn_readfirstlane(tid >> 6); \
    const int G = gridDim.x, bx = blockIdx.x, vcu = (G % 8 == 0) ? (bx % 8) * (G / 8) + bx / 8 : bx; unsigned char* ws = AWS; (void)lane; (void)wave; (void)vcu; (void)ws; (void)bx;
    if (IN(0)) for (int rep = 0; rep < NREP(0); ++rep) { PHASE_VARS; p0_prologue(kp, lds, tid, wave, lane, vcu, G); if (rep + 1 < NREP(0)) xcd_barrier(bar, TIDX()); }
    SEAM(0);
    if (IN(1)) for (int rep = 0; rep < NREP(1); ++rep) { PHASE_VARS; p1_pass(kp, tid, wave, lane, vcu, G); }
    SEAM(1);
    if (IN(2)) { PHASE_VARS; pg8::Gemm g{(const bf16_t*)(ws + WS_HH), (const bf16_t*)(ws + WS_W13A), DM, DM, DM, 0, 0}; pg8::Order S; S.init(24, 22, 1, G, bx);
        pg8::EpiSwiGLU E{(bf16_t*)(ws + WS_R + R_U), (const float*)(ws + WS_CTL) + CW_ROWSS, (const float*)(ws + WS_MISC + MISC_SW) + SW_A}; pg8::gemm_phase<pg8::EpiSwiGLU, true>(lds, g, S, E, tid);
        if (bx >= 16 && G > 16) for (int frep = 0; frep < FILL_REP; ++frep) { p0_transposes(kp, lds, wave, lane, (bx - 16) * NWAVES + wave, (G - 16) * NWAVES, 1); p0_misc(kp, (bx - 16) * 512 + tid, (G - 16) * 512); } }
    SEAM(2);
    if (IN(3)) { PHASE_VARS; pg8::Gemm g{(const bf16_t*)(ws + WS_R + R_U), (const bf16_t*)(ws + WS_W2A), FF, FF, FF / 2, FF / 2, FF / 2}; pg8::Order S; S.init(32, 4, 2, G, bx);
        pg8::EpiCombine<0> E{(float*)(ws + WS_R + R_SLAB), (unsigned*)(ws + WS_CTL) + CW_FLG, AIN(I_XP), AIN(I_XS), AOUT + O_Y, (bf16_t*)(ws + WS_HH),
            (float*)(ws + WS_CTL) + CW_ROWSS + MROWS, (LAS float*)(lds + pg8::STAGE_BYTES), (const float*)(ws + WS_MISC + MISC_MODS), (const float*)(ws + WS_MISC + MISC_GS)};
        pg8::gemm_phase<pg8::EpiCombine<0>, true, 3>(lds, g, S, E, tid); }
    SEAM(3);
    if (IN(4)) for (int rep = 0; rep < NREP(4); ++rep) { PHASE_VARS; pg8::Gemm g{(const bf16_t*)(ws + WS_HH), (const bf16_t*)(ws + WS_WIN), DM, DM, DM, 0, 0}; pg8::OrderMixed S; S.o.init(24, 37, 1, G, bx);
        pg8::EpiProj E{ws + WS_R, AOUT + O_NEWK, AOUT + O_NEWV, AIN(I_GQN), AIN(I_GKN), (LAS float*)(lds + pg8::STAGE_BYTES), (const float*)(ws + WS_MISC + MISC_ROPE), (const float*)(ws + WS_CTL) + CW_ROWSS + MROWS,
            (const float*)(ws + WS_MISC + MISC_SW) + SW_C, AIN(I_BGATE), (float*)(ws + WS_G)};
        pg8::gemm_phase<pg8::EpiProj, true, 4, pg8::OrderMixed>(lds, g, S, E, tid);
        if (bx >= 120 && G > 120 && rep == 0) for (int frep = 0; frep < FILL_REP4; ++frep) p0_transposes(kp, lds, wave, lane, (bx - 120) * NWAVES + wave, (G - 120) * NWAVES, 2, frep == 0); if (NREP(4) > 1) __syncthreads(); }
    SEAM(4);
    if (IN(5)) for (int rep = 0; rep < NREP(5); ++rep) {
        PHASE_VARS; unsigned* ctl = (unsigned*)(ws + WS_CTL);
        const float lam = *(const float*)(ws + WS_MISC + MISC_LAM);
        for (;;) {
            __syncthreads();
            if (tid == 0) MISC[16] = xb_add(ctl + CW_QUEUE + 64 * rep, 1u);
            __syncthreads();
            int u = __builtin_amdgcn_readfirstlane((int)MISC[16]);
#if defined(REP_CLASS)
            { constexpr int c0 = REP_CLASS == 0 ? 0 : REP_CLASS == 1 ? 64 : REP_CLASS == 2 ? 192 : 704, cn = REP_CLASS == 0 ? 64 : REP_CLASS == 1 ? 128 : REP_CLASS == 2 ? 512 : 256;
              if (u >= 960 + cn) break;
              if (u >= 960) u = c0 + (u - 960); }
#else
            if (u >= 960) break;
#endif
            int is_attn, latf, i;
            if (u < 64) { is_attn = 0; latf = 1; i = u; } else if (u < 192) { is_attn = 1; latf = 1; i = u - 64; } else if (u < 704) { is_attn = 0; latf = 0; i = u - 192; } else { is_attn = 1; latf = 0; i = u - 704; }
            KP kpu = kp0; asm volatile("" : "+s"(kpu)); int tidu = TIDX(); asm volatile("" : "+v"(tidu));
            const int laneu = tidu & 63, waveu = __builtin_amdgcn_readfirstlane(tidu >> 6);
            if (is_attn) {
                if (latf) attn_unit(kpu, lds, 1, i >> 6, (i >> 3) & 7, i & 7, lam, tidu, waveu, laneu); else attn_unit(kpu, lds, 0, i >> 4, (i >> 1) & 7, i & 1, lam, tidu, waveu, laneu);
            } else {
                mlstm_unit(kpu, lds, latf, i >> 5, (i >> 3) & 3, (i >> 2) & 1, i & 3, tidu, waveu, laneu);
            }
        }
    }
    SEAM2(5, 7);
    if (IN(7)) for (int rep = 0; rep < NREP(7); ++rep) { PHASE_VARS; pg8::Gemm g{(const bf16_t*)(ws + WS_AB), (const bf16_t*)(ws + WS_WBR), 2048, DM, DM, 1024, (size_t)DM * DM}; pg8::Order S; S.init(32, 4, 2, G, bx);
        pg8::Unit u0; const bool has0 = S.next(0, u0);
        if (rep == 0 && has0) hm_rows(kp, u0.pm, u0.pn, u0.z, tid, wave, lane);
        pg8::EpiBranch E{(bf16_t*)(ws + WS_R + R_P), ws + WS_R}; pg8::gemm_phase<pg8::EpiBranch, false, 3>(lds, g, S, E, tid);
        asm volatile("s_waitcnt vmcnt(0)" ::: "memory"); __syncthreads();
        if (rep == 0 && has0 && tid == 0) __hip_atomic_store((unsigned*)(ws + WS_CTL) + CW_DFT + 1024 + (u0.pm * 2 + u0.z) * 4 + u0.pn, 1u, __ATOMIC_RELAXED, __HIP_MEMORY_SCOPE_AGENT); }
    if (IN(8)) { PHASE_VARS; pg8::Gemm g{(const bf16_t*)(ws + WS_R + R_P), (const bf16_t*)(ws + WS_WOUT), 2048, DM, DM, 1024, 0}; pg8::Order S; S.init(32, 4, 2, G, bx);
        { pg8::Unit u0; if (IN(7) && S.next(0, u0)) {
            if (tid < 64) { unsigned* f = (unsigned*)(ws + WS_CTL) + CW_DFT + 1024 + (u0.pm * 2 + u0.z) * 4; unsigned sp = 0u;
                for (;;) { const unsigned v = __hip_atomic_load(f + (lane & 3), __ATOMIC_RELAXED, __HIP_MEMORY_SCOPE_AGENT);
                    if (__builtin_amdgcn_ballot_w64(v == 0u) == 0ull || ++sp > (1u << 22)) break;
                    __builtin_amdgcn_s_sleep(2); }
                __builtin_amdgcn_fence(__ATOMIC_ACQUIRE, "agent"); }
            asm volatile("s_waitcnt vmcnt(0) lgkmcnt(0)" ::: "memory"); __syncthreads(); } }
        pg8::EpiCombine<1> E{(float*)(ws + WS_WIN),
 (unsigned*)(ws + WS_CTL) + CW_FLG + 512, AIN(I_XP), AIN(I_XS), AOUT + O_Y, (bf16_t*)(ws + WS_HH),
            (float*)(ws + WS_CTL) + CW_ROWSS + 2 * MROWS, (LAS float*)(lds + pg8::STAGE_BYTES), (const float*)(ws + WS_MISC + MISC_MODS), (const float*)(ws + WS_MISC + MISC_GS)};
        pg8::gemm_phase<pg8::EpiCombine<1>, true, 3>(lds, g, S, E, tid); }
    SEAM(8);
    if (IN(9)) for (int rep = 0; rep < NREP(9); ++rep) { PHASE_VARS; pg8::Gemm g{(const bf16_t*)(ws + WS_HH), (const bf16_t*)(ws + WS_W13B), DM, DM, DM, 0, 0}; pg8::Order S; S.init(32, 22, 1, G, bx);
        pg8::EpiSwiGLU E{(bf16_t*)(ws + WS_R + R_U), (const float*)(ws + WS_CTL) + CW_ROWSS + 2 * MROWS, (const float*)(ws + WS_MISC + MISC_SW) + SW_F}; pg8::gemm_phase<pg8::EpiSwiGLU, true, 3>(lds, g, S, E, tid); }
    SEAM(9);
    if (IN(10)) { PHASE_VARS; pg8::Gemm g{(const bf16_t*)(ws + WS_R + R_U), (const bf16_t*)(ws + WS_W2B), FF, FF, FF / 2, FF / 2, FF / 2}; pg8::Order S; S.init(32, 4, 2, G, bx);
        pg8::EpiCombine<2> E{(float*)(ws + WS_R + R_SLAB), (unsigned*)(ws + WS_CTL) + CW_FLG + 1024, AIN(I_XP), AIN(I_XS), AOUT + O_Y, (bf16_t*)(ws + WS_HH),
            (float*)(ws + WS_CTL) + CW_ROWSS, (LAS float*)(lds + pg8::STAGE_BYTES), (const float*)(ws + WS_MISC + MISC_MODS), (const float*)(ws + WS_MISC + MISC_GS)};
        pg8::gemm_phase<pg8::EpiCombine<2>, true, 3>(lds, g, S, E, tid); }
#undef IN
#undef SEAM
#undef SEAM2
}

extern "C" void kernel_launch(void* const* d_in, const int* in_sizes, int n_in, void* d_out, int out_size, void* d_ws, size_t ws_size, hipStream_t stream) {
    static int grid = 0;
    if (grid == 0) {
        if (n_in != 31 || (size_t)out_size != O_END || ws_size < WS_END) { fprintf(stderr, "kernel_launch: unexpected shapes (n_in %d, out %d, ws %zu)\n", n_in, out_size, ws_size); grid = -1; return; }
        int dev = 0, cus = 0;
        if (hipGetDevice(&dev) != hipSuccess || hipDeviceGetAttribute(&cus, hipDeviceAttributeMultiprocessorCount, dev) != hipSuccess) { grid = -1; return; }
        if (hipFuncSetAttribute((const void*)fwd_kernel, hipFuncAttributeMaxDynamicSharedMemorySize, LDS_BYTES) != hipSuccess) { grid = -1; return; }
        grid = cus;
    }
    if (grid < 0) return;
    (void)hipMemsetAsync((char*)d_ws + WS_CTL, 0, CTL_ZERO_BYTES, stream);
    Args a{};
    for (int i = 0; i < 31; ++i) a.in[i] = (const float*)d_in[i];
    a.out = (float*)d_out; a.ws = (unsigned char*)d_ws;
#if MK_N_LAUNCHES == 1
    a.ph_lo = 0; a.ph_hi = N_PHASES;
    hipLaunchKernelGGL(fwd_kernel, dim3(grid), dim3(NWAVES * 64), LDS_BYTES, stream, a);
#else
    for (int p = 0; p < N_PHASES; ++p) { a.ph_lo = p; a.ph_hi = p + 1; hipLaunchKernelGGL(fwd_kernel, dim3(grid), dim3(NWAVES * 64), LDS_BYTES, stream, a); }
#endif
}
```
